# Optimizing an MI355X kernel written in HIP

```python
import jax, jax.numpy as jnp
from jax import lax
import numpy as np

D_MODEL = 1024
BATCH = 8
SEQ = 8192
DEPTH = 1

MLSTM_HEADS = 4
MLSTM_HEAD_DIM = 128
MLSTM_WIDTH = MLSTM_HEADS * MLSTM_HEAD_DIM
MLSTM_CHUNK = 128
N_GATES = 4 * MLSTM_HEADS
MLA_HEADS = 4
QK_NOPE = 128
QK_ROPE = 64
V_HEAD = 128
Q_LORA = 256
KV_LORA = 128
MLA_WIDTH = MLA_HEADS * V_HEAD
Q_BLOCK = 128
ROPE_THETA = 10000.0
D_MIX = MLSTM_WIDTH + MLA_WIDTH
OFF_Q = 0
OFF_K = OFF_Q + MLSTM_WIDTH
OFF_V = OFF_K + MLSTM_WIDTH
OFF_O = OFF_V + MLSTM_WIDTH
OFF_G = OFF_O + MLSTM_WIDTH
OFF_CQ = OFF_G + N_GATES
OFF_CKV = OFF_CQ + Q_LORA
OFF_KR = OFF_CKV + KV_LORA
IN_COLS = OFF_KR + QK_ROPE
D_FF = 2816
CONV_WIDTH = 3
PLE_DIM = 256
EPS = 1e-6

kernel_name = 'hybrid_mlstm_mla_convffn_block'


def rms_norm(x, g):
    xf = x.astype(jnp.float32)
    y = xf * lax.rsqrt(jnp.mean(xf * xf, axis=-1, keepdims=True) + EPS)
    return (y * g.astype(jnp.float32)).astype(x.dtype)


def dwconv3_centred(x, w, b):
    xp = jnp.pad(x, ((0, 0), (1, 1), (0, 0)))
    return xp[:, :-2] * w[0] + xp[:, 1:-1] * w[1] + xp[:, 2:] * w[2] + b


def apply_rope(x, cos, sin):
    xf = x.astype(jnp.float32)
    x1, x2 = jnp.split(xf, 2, axis=-1)
    return jnp.concatenate([x1 * cos - x2 * sin, x2 * cos + x1 * sin], axis=-1).astype(x.dtype)


def mlstm_chunkwise(q, k, v, i_pre, f_pre):
    b, nh, s, dh = q.shape
    L = MLSTM_CHUNK
    nc = s // L
    qc = q.reshape(b, nh, nc, L, dh)
    kc = k.reshape(b, nh, nc, L, dh)
    vc = v.reshape(b, nh, nc, L, dh)
    log_f = jax.nn.log_sigmoid(f_pre).reshape(b, nh, nc, L)
    log_i = i_pre.reshape(b, nh, nc, L)
    g = jnp.cumsum(log_f, axis=-1)
    g_last = g[..., -1]
    a = g_last[..., None] - g + log_i
    m_loc = jnp.max(a, axis=-1)
    w = jnp.exp(a - m_loc[..., None])
    c_loc = jnp.einsum('bhcsd,bhcse->bhcde', vc * w[..., None], kc)
    n_loc = jnp.einsum('bhcs,bhcse->bhce', w, kc)

    def step(carry, inp):
        c_st, n_st, m_st = carry
        gl, ml, cl, nl = inp
        m_new = jnp.maximum(gl + m_st, ml)
        s_old = jnp.exp(gl + m_st - m_new)
        s_new = jnp.exp(ml - m_new)
        c_next = s_old[..., None, None] * c_st + s_new[..., None, None] * cl
        n_next = s_old[..., None] * n_st + s_new[..., None] * nl
        return (c_next, n_next, m_new), (c_st, n_st, m_st)

    init = (jnp.zeros((b, nh, dh, dh), q.dtype), jnp.zeros((b, nh, dh), q.dtype),
            jnp.zeros((b, nh), q.dtype))
    xs = (jnp.moveaxis(g_last, 2, 0), jnp.moveaxis(m_loc, 2, 0),
          jnp.moveaxis(c_loc, 2, 0), jnp.moveaxis(n_loc, 2, 0))
    _, (c_prev, n_prev, m_prev) = lax.scan(step, init, xs)
    c_prev = jnp.moveaxis(c_prev, 0, 2)
    n_prev = jnp.moveaxis(n_prev, 0, 2)
    m_prev = jnp.moveaxis(m_prev, 0, 2)

    lower_tri = jnp.tril(jnp.ones((L, L), dtype=bool))
    d = jnp.where(lower_tri, g[..., :, None] - g[..., None, :] + log_i[..., None, :], -jnp.inf)
    b_inter = g + m_prev[..., None]
    m_t = jnp.maximum(jnp.max(d, axis=-1), b_inter)
    scores = jnp.einsum('bhctd,bhcsd->bhcts', qc, kc) * jnp.exp(d - m_t[..., None])
    inter = jnp.exp(b_inter - m_t)
    num = (jnp.einsum('bhcts,bhcsd->bhctd', scores, vc)
           + inter[..., None] * jnp.einsum('bhcde,bhcte->bhctd', c_prev, qc))
    den = jnp.sum(scores, axis=-1) + inter * jnp.einsum('bhce,bhcte->bhct', n_prev, qc)
    out = num / jnp.maximum(jnp.abs(den), jnp.exp(-m_t))[..., None]
    return out.reshape(b, nh, s, dh)


def mlstm_group(q_pre, k_pre, v_pre, o_pre, gates, conv_w, conv_b, norm_g):
    bsz, s, _ = v_pre.shape
    qk = jax.nn.silu(dwconv3_centred(jnp.concatenate([q_pre, k_pre], axis=-1), conv_w, conv_b))
    q, k = jnp.split(qk, 2, axis=-1)

    def heads(t):
        return t.reshape(bsz, s, MLSTM_HEADS, MLSTM_HEAD_DIM).transpose(0, 2, 1, 3).astype(jnp.float32)

    q = heads(q)
    k = heads(k) * (MLSTM_HEAD_DIM ** -0.5)
    v = heads(v_pre)
    gt = gates.astype(jnp.float32).reshape(bsz, s, 4, MLSTM_HEADS).transpose(2, 0, 3, 1)
    h_fwd = mlstm_chunkwise(q, k, v, gt[0], gt[1])
    flip = lambda t: jnp.flip(t, axis=2)
    h_bwd = flip(mlstm_chunkwise(flip(q), flip(k), flip(v), flip(gt[2]), flip(gt[3])))
    h = (h_fwd + h_bwd).transpose(0, 2, 1, 3)
    h = rms_norm(h, norm_g.reshape(MLSTM_HEADS, MLSTM_HEAD_DIM))
    h = h.reshape(bsz, s, MLSTM_WIDTH).astype(v_pre.dtype)
    return jax.nn.sigmoid(o_pre) * h


def mla_group(c_q, c_kv, k_rope_pre, q_norm_g, w_uq, kv_norm_g, w_ukv, cos, sin):
    bsz, s, _ = c_q.shape
    q = (rms_norm(c_q, q_norm_g) @ w_uq).reshape(bsz, s, MLA_HEADS, QK_NOPE + QK_ROPE)
    q_nope, q_rope = q[..., :QK_NOPE], q[..., QK_NOPE:]
    q_rope = apply_rope(q_rope, cos[:, None, :], sin[:, None, :])
    kv = (rms_norm(c_kv, kv_norm_g) @ w_ukv).reshape(bsz, s, MLA_HEADS, QK_NOPE + V_HEAD)
    k_nope, v = kv[..., :QK_NOPE], kv[..., QK_NOPE:]
    k_rope = apply_rope(k_rope_pre, cos, sin)
    scale = (QK_NOPE + QK_ROPE) ** -0.5
    nb = s // Q_BLOCK

    def to_blocks(t):
        return jnp.moveaxis(t.reshape(bsz, nb, Q_BLOCK, *t.shape[2:]), 1, 0)

    def attend(blk):
        qn, qr = blk
        sc = (jnp.einsum('bqhd,bkhd->bhqk', qn, k_nope)
              + jnp.einsum('bqhr,bkr->bhqk', qr, k_rope))
        pr = jax.nn.softmax(sc.astype(jnp.float32) * scale, axis=-1)
        return jnp.einsum('bhqk,bkhd->bqhd', pr.astype(v.dtype), v)

    o = lax.map(attend, (to_blocks(q_nope), to_blocks(q_rope)))
    return jnp.moveaxis(o, 0, 1).reshape(bsz, s, MLA_WIDTH)


def conv_gated_mlp(xn, w_up, conv_w, conv_b, w_down):
    u = dwconv3_centred(xn @ w_up, conv_w, conv_b)
    gate, val = jnp.split(u, 2, axis=-1)
    return (jax.nn.silu(gate) * val) @ w_down


def setup_inputs(seed: int = 0) -> dict:
    key = jax.random.key(seed)
    ks = jax.random.split(key, 24)
    f32 = jnp.float32

    def nrm(k, shape, scale):
        return jax.random.normal(k, shape, f32) * scale

    def gain(k, shape):
        return 1.0 + 0.02 * jax.random.normal(k, shape, f32)

    gate_i = nrm(ks[4], (DEPTH, 2, MLSTM_HEADS), 0.1)
    gate_f = jnp.linspace(3.0, 6.0, MLSTM_HEADS, dtype=f32) + nrm(ks[5], (DEPTH, 2, MLSTM_HEADS), 0.1)
    b_gates = jnp.stack([gate_i, gate_f], axis=2).reshape(DEPTH, N_GATES)
    return {
        'x': nrm(ks[0], (BATCH, SEQ, D_MODEL), 1.0),
        'p': nrm(ks[1], (DEPTH, BATCH, SEQ, PLE_DIM), 1.0),
        'ln_mix_g': gain(ks[2], (DEPTH, D_MODEL)),
        'w_in': nrm(ks[3], (DEPTH, D_MODEL, IN_COLS), D_MODEL ** -0.5),
        'b_gates': b_gates,
        'conv_qk_w': nrm(ks[6], (DEPTH, CONV_WIDTH, 2 * MLSTM_WIDTH), CONV_WIDTH ** -0.5),
        'conv_qk_b': nrm(ks[7], (DEPTH, 2 * MLSTM_WIDTH), 0.02),
        'mlstm_norm_g': gain(ks[8], (DEPTH, MLSTM_WIDTH)),
        'q_norm_g': gain(ks[9], (DEPTH, Q_LORA)),
        'w_uq': nrm(ks[10], (DEPTH, Q_LORA, MLA_HEADS * (QK_NOPE + QK_ROPE)), Q_LORA ** -0.5),
        'kv_norm_g': gain(ks[11], (DEPTH, KV_LORA)),
        'w_ukv': nrm(ks[12], (DEPTH, KV_LORA, MLA_HEADS * (QK_NOPE + V_HEAD)), KV_LORA ** -0.5),
        'w_out': nrm(ks[13], (DEPTH, D_MIX, D_MODEL), D_MIX ** -0.5),
        'ln_ffn_g': gain(ks[14], (DEPTH, D_MODEL)),
        'w_up': nrm(ks[15], (DEPTH, D_MODEL, 2 * D_FF), D_MODEL ** -0.5),
        'conv_ffn_w': nrm(ks[16], (DEPTH, CONV_WIDTH, 2 * D_FF), CONV_WIDTH ** -0.5),
        'conv_ffn_b': nrm(ks[17], (DEPTH, 2 * D_FF), 0.02),
        'w_down': nrm(ks[18], (DEPTH, D_FF, D_MODEL), D_FF ** -0.5),
        'ple_norm_g': gain(ks[19], (DEPTH, D_MODEL)),
        'w_ple_gate': nrm(ks[20], (DEPTH, D_MODEL, D_MODEL), D_MODEL ** -0.5),
        'w_ple_proj': nrm(ks[21], (DEPTH, PLE_DIM, D_MODEL), PLE_DIM ** -0.5),
        'ple_post_g': gain(ks[22], (DEPTH, D_MODEL)),
        'final_g': gain(ks[23], (D_MODEL,)),
    }


def reference(x, p, ln_mix_g, w_in, b_gates, conv_qk_w, conv_qk_b, mlstm_norm_g,
              q_norm_g, w_uq, kv_norm_g, w_ukv, w_out, ln_ffn_g, w_up, conv_ffn_w,
              conv_ffn_b, w_down, ple_norm_g, w_ple_gate, w_ple_proj, ple_post_g, final_g):
    s = x.shape[1]
    pos = jnp.arange(s, dtype=jnp.float32)
    inv_freq = ROPE_THETA ** (-jnp.arange(0, QK_ROPE, 2, dtype=jnp.float32) / QK_ROPE)
    ang = pos[:, None] * inv_freq[None, :]
    cos, sin = jnp.cos(ang), jnp.sin(ang)
    h = x
    for l in range(DEPTH):
        xn = rms_norm(h, ln_mix_g[l])
        proj = xn @ w_in[l]
        y_a = mlstm_group(proj[..., OFF_Q:OFF_K], proj[..., OFF_K:OFF_V],
                          proj[..., OFF_V:OFF_O], proj[..., OFF_O:OFF_G],
                          proj[..., OFF_G:OFF_CQ] + b_gates[l],
                          conv_qk_w[l], conv_qk_b[l], mlstm_norm_g[l])
        y_b = mla_group(proj[..., OFF_CQ:OFF_CKV], proj[..., OFF_CKV:OFF_KR],
                        proj[..., OFF_KR:IN_COLS], q_norm_g[l], w_uq[l],
                        kv_norm_g[l], w_ukv[l], cos, sin)
        h = h + jnp.concatenate([y_a, y_b], axis=-1) @ w_out[l]
        h = h + conv_gated_mlp(rms_norm(h, ln_ffn_g[l]), w_up[l], conv_ffn_w[l],
                               conv_ffn_b[l], w_down[l])
        gate = jax.nn.sigmoid(rms_norm(h, ple_norm_g[l]) @ w_ple_gate[l])
        h = h + gate * rms_norm(p[l] @ w_ple_proj[l], ple_post_g[l])
    return rms_norm(h, final_g)
```

```cpp
#include <hip/hip_runtime.h>
#include <hip/hip_bf16.h>
#include <hip/hip_cooperative_groups.h>
#include <cstdio>
#include <cstdint>
#include <cmath>
namespace cg = cooperative_groups;
#ifndef MK_REP_SMALL
#define MK_REP_SMALL 1
#endif
#ifndef MK_REP_P2
#define MK_REP_P2 1
#endif
#ifndef MK_REP_SYNC
#define MK_REP_SYNC 1
#endif
#ifndef MK_REP_UP
#define MK_REP_UP 1
#endif
#ifndef MK_REP_ML
#define MK_REP_ML 1
#endif
#ifndef MK_REP_ATT
#define MK_REP_ATT 1
#endif
#ifndef MK_N_LAUNCHES
#define MK_N_LAUNCHES 1
#endif
namespace pg8 {
#define PG8_LAS __attribute__((address_space(3)))
typedef unsigned short bf16_t;
typedef short bf16x8 __attribute__((ext_vector_type(8)));
typedef float f32x4 __attribute__((ext_vector_type(4)));
typedef unsigned u32x4 __attribute__((ext_vector_type(4)));
constexpr int BM = 256, BK = 64, HALF = 128, HTB = HALF * BK * 2  , STAGE_BYTES = 8 * HTB, NXCD = 8, WGM = 8;

__host__ __device__ __forceinline__ int lds_byte(int r, int c) { const int st = (r >> 4) * 2 + (c >> 5), rr = r & 15, cc = c & 31, ob = rr * 64 + cc * 2; return st * 1024 + (ob ^ (((ob >> 9) & 1) << 5)); }
__host__ __device__ __forceinline__ void stage_rc(int b, int& R, int& C) { const int st = b / 1024, sb = b % 1024, swz = sb ^ (((sb >> 9) & 1) << 5); R = (st >> 1) * 16 + swz / 64; C = (st & 1) * 32 + (swz % 64) / 2; }
__host__ __device__ __forceinline__ int perm32(int rho) { const int n = rho >> 4, i = rho & 15; return 8 * (i >> 2) + 4 * n + (i & 3); }

struct Unit { int pm, pn; };
struct Gemm { const bf16_t* A; const bf16_t* Bt; int M, N, K, lda, amode; };
__host__ __device__ __forceinline__ size_t arow0(const Gemm& g, int pm) { return g.amode ? (size_t)(pm / 33) * 8192 + (size_t)(pm % 33) * 252 : (size_t)pm * 256; }

struct StaticOrder {
    int nM, nN, nwg, G, c;
    __host__ __device__ void init(int M, int N, int G_, int c_) { nM = M / BM; nN = N / BM; nwg = nM * nN; G = G_; c = c_; }
    __host__ __device__ bool next(int i, Unit& u) const {
        const long L = (long)i * G + c; if (L >= nwg) return false;
        int wgid = (int)L; { const int q = nwg / NXCD, r = nwg % NXCD, xcd = wgid % NXCD, off = wgid / NXCD; wgid = (xcd < r ? xcd * (q + 1) : r * (q + 1) + (xcd - r) * q) + off; }
        const int nig = WGM * nN, gid = wgid / nig, fm = gid * WGM, gsz = (nM - fm) < WGM ? (nM - fm) : WGM;
        u.pm = fm + ((wgid % nig) % gsz); u.pn = (wgid % nig) / gsz; return true;
    }
    __device__ __forceinline__ void a_ready(const Unit&) const {}
    __device__ __forceinline__ void done(const Unit&) const {}
};

__device__ __forceinline__ unsigned cvt_pk_bf16(float lo, float hi) { unsigned r; asm volatile("v_cvt_pk_bf16_f32 %0, %1, %2" : "=v"(r) : "v"(lo), "v"(hi)); return r; }
typedef float f32x2 __attribute__((ext_vector_type(2)));
__device__ __forceinline__ f32x2 gelu_pk(f32x2 v) {
    const f32x2 av = __builtin_elementwise_abs(v), d = av * 0.2316418882f + 1.0f;
    f32x2 t; t.x = __builtin_amdgcn_rcpf(d.x); t.y = __builtin_amdgcn_rcpf(d.y);
    f32x2 q = t * 0.5307027145f + (-0.7265760135f); q = q * t + 0.7107068705f; q = q * t + (-0.142248368f); q = q * t + 0.127414796f; q = q * t;
    const f32x2 s = (v * v) * (-0.72134752044f);
    f32x2 e; e.x = __builtin_amdgcn_exp2f(s.x); e.y = __builtin_amdgcn_exp2f(s.y);
    const f32x2 m = v * (q * e), r = v - m;
    f32x2 o; o.x = v.x < 0.f ? m.x : r.x; o.y = v.y < 0.f ? m.y : r.y; return o;
}

template <int ACT  > struct EpiBf16 {
    static constexpr bool PERM = true, AFTER_DRAIN = false; static_assert(ACT == 0 || ACT == 1, "EpiBf16: ACT is 0 (none) or 1 (gelu_pk)");
    bf16_t* O; int ldc; const float* bias; int split_cols; size_t split_stride; float scale0;
    __device__ __forceinline__ void operator()(const f32x4 (&acc)[2][2][4][2], const Unit& u, int wr, int wc, int fr, int fq) const {
        const int row0 = u.pm * BM + wr * 64 + fr; int colt = u.pn * BM; bf16_t* base = O;
        float sc = 1.f; if (split_cols) { const int t = colt / split_cols; base += (size_t)t * split_stride; colt -= t * split_cols; if (t == 0) sc = scale0; }
        const int col0 = colt + wc * 32 + 8 * fq, bcol0 = u.pn * BM + wc * 32 + 8 * fq;
        f32x4 bv[2][2];
#pragma unroll
        for (int bj = 0; bj < 2; ++bj)
#pragma unroll
            for (int n = 0; n < 2; ++n) bv[bj][n] = bias ? *(const f32x4*)(bias + bcol0 + bj * HALF + 4 * n) : (f32x4){0.f, 0.f, 0.f, 0.f};
#pragma unroll
        for (int ai = 0; ai < 2; ++ai)
#pragma unroll
            for (int m = 0; m < 4; ++m) { bf16_t* rowp = base + (size_t)(row0 + ai * HALF + m * 16) * ldc + col0;
#pragma unroll
                for (int bj = 0; bj < 2; ++bj) { f32x4 v0 = acc[ai][bj][m][0] + bv[bj][0], v1 = acc[ai][bj][m][1] + bv[bj][1];
                    if (ACT == 1) { f32x2 a = gelu_pk((f32x2){v0[0], v0[1]}), b = gelu_pk((f32x2){v0[2], v0[3]}), c = gelu_pk((f32x2){v1[0], v1[1]}), d = gelu_pk((f32x2){v1[2], v1[3]});
                        v0 = (f32x4){a.x, a.y, b.x, b.y}; v1 = (f32x4){c.x, c.y, d.x, d.y}; }
                    v0 = v0 * sc; v1 = v1 * sc; u32x4 w; w.x = cvt_pk_bf16(v0[0], v0[1]); w.y = cvt_pk_bf16(v0[2], v0[3]); w.z = cvt_pk_bf16(v1[0], v1[1]); w.w = cvt_pk_bf16(v1[2], v1[3]);
                    *(u32x4*)(rowp + bj * HALF) = w; } }
    }
};
struct PanelOrder {
    int c, G, nM;
    __host__ __device__ bool next(int i, Unit& u) const { const int pm = c + (i >> 2) * G; if (pm >= nM) return false; u.pm = pm; u.pn = (i + (c >> 3)) & 3; return true; }
    __device__ __forceinline__ void a_ready(const Unit&) const {}
    __device__ __forceinline__ void done(const Unit&) const {}
};
#define MK_EPS 1e-6f
__device__ __forceinline__ float sq4(f32x4 v) { return (v[0] * v[0] + v[1] * v[1]) + (v[2] * v[2] + v[3] * v[3]); }
__device__ __forceinline__ float red_fq(float s) { s += __shfl_xor(s, 16); s += __shfl_xor(s, 32); return s; }
__device__ __forceinline__ u32x4 pack8(f32x4 v0, f32x4 v1) { u32x4 w; w.x = cvt_pk_bf16(v0[0], v0[1]); w.y = cvt_pk_bf16(v0[2], v0[3]); w.z = cvt_pk_bf16(v1[0], v1[1]); w.w = cvt_pk_bf16(v1[2], v1[3]); return w; }
__device__ __forceinline__ float bf_lo(unsigned w) { return __uint_as_float(w << 16); }
__device__ __forceinline__ float bf_hi(unsigned w) { return __uint_as_float(w & 0xffff0000u); }

struct EpiProj {
    static constexpr bool PERM = true, AFTER_DRAIN = false;
    bf16_t* O; int ldc; float* ssq; float* sskv;
    __device__ __forceinline__ void operator()(const f32x4 (&acc)[2][2][4][2], const Unit& u, int wr, int wc, int fr, int fq) const {
        const int row0 = u.pm * BM + wr * 64 + fr, col0 = u.pn * BM + wc * 32 + 8 * fq;
#pragma unroll
        for (int ai = 0; ai < 2; ++ai)
#pragma unroll
            for (int m = 0; m < 4; ++m) { const int row = row0 + ai * HALF + m * 16; bf16_t* rowp = O + (size_t)row * ldc + col0; float s0 = 0.f, s1 = 0.f;
#pragma unroll
                for (int bj = 0; bj < 2; ++bj) { const f32x4 v0 = acc[ai][bj][m][0], v1 = acc[ai][bj][m][1]; *(u32x4*)(rowp + bj * HALF) = pack8(v0, v1);
                    const float q = sq4(v0) + sq4(v1); if (bj == 0) s0 += q; else s1 += q; }
                if (u.pn == 8) { const float s = red_fq(s0 + s1); if (fq == 0) unsafeAtomicAdd(ssq + row, s); }
                else if (u.pn == 9) { const float s = red_fq(s0); if (fq == 0) unsafeAtomicAdd(sskv + row, s); } }
    }
};
struct EpiScale {
    static constexpr bool PERM = true, AFTER_DRAIN = false;
    bf16_t* O; int ldc; const float* ss_in; float inv_dim; float* ss_out;
    __device__ __forceinline__ void operator()(const f32x4 (&acc)[2][2][4][2], const Unit& u, int wr, int wc, int fr, int fq) const {
        const int row0 = u.pm * BM + wr * 64 + fr, col0 = u.pn * BM + wc * 32 + 8 * fq;
#pragma unroll
        for (int ai = 0; ai < 2; ++ai)
#pragma unroll
            for (int m = 0; m < 4; ++m) { const int row = row0 + ai * HALF + m * 16; bf16_t* rowp = O + (size_t)row * ldc + col0; float s = 0.f;
                const float sc = ss_in ? rsqrtf(ss_in[row] * inv_dim + MK_EPS) : 1.f;
#pragma unroll
                for (int bj = 0; bj < 2; ++bj) { const f32x4 v0 = acc[ai][bj][m][0] * sc, v1 = acc[ai][bj][m][1] * sc; *(u32x4*)(rowp + bj * HALF) = pack8(v0, v1); s += sq4(v0) + sq4(v1); }
                if (ss_out) { s = red_fq(s); if (fq == 0) unsafeAtomicAdd(ss_out + row, s); } }
    }
};
struct EpiResid {
    static constexpr bool PERM = true, AFTER_DRAIN = false;
    const float* base; float* out; bf16_t* ob; int ldc; float* ss_out;
    __device__ __forceinline__ void operator()(const f32x4 (&acc)[2][2][4][2], const Unit& u, int wr, int wc, int fr, int fq) const {
        const int row0 = u.pm * BM + wr * 64 + fr, col0 = u.pn * BM + wc * 32 + 8 * fq;
#pragma unroll
        for (int ai = 0; ai < 2; ++ai)
#pragma unroll
            for (int m = 0; m < 4; ++m) { const int row = row0 + ai * HALF + m * 16; const size_t off = (size_t)row * ldc + col0; float s = 0.f;
#pragma unroll
                for (int bj = 0; bj < 2; ++bj) { const f32x4 b0 = *(const f32x4*)(base + off + bj * HALF), b1 = *(const f32x4*)(base + off + bj * HALF + 4);
                    const f32x4 v0 = acc[ai][bj][m][0] + b0, v1 = acc[ai][bj][m][1] + b1;
                    *(f32x4*)(out + off + bj * HALF) = v0; *(f32x4*)(out + off + bj * HALF + 4) = v1; *(u32x4*)(ob + off + bj * HALF) = pack8(v0, v1); s += sq4(v0) + sq4(v1); }
                s = red_fq(s); if (fq == 0) unsafeAtomicAdd(ss_out + row, s);
                if (m & 1) asm volatile("" ::: "memory"); }
    }
};

struct EpiConvAct {
    static constexpr bool PERM = true, AFTER_DRAIN = false;
    bf16_t* act; const float* ss1; const float* cw; const float* cb;
    __device__ __forceinline__ void operator()(f32x4 (&acc)[2][2][4][2], const Unit& u, int wr, int wc, int fr, int fq) const {
        const int seq = u.pm / 33, p0 = 252 * (u.pm % 33) + 126 * wr + 8 * fr - 1;
        const size_t tokb = (size_t)seq * 8192; const int col = u.pn * 128 + wc * 32 + 8 * fq;
        { const float* sp = ss1 + tokb;
#pragma unroll
          for (int ai = 0; ai < 2; ++ai)
#pragma unroll
            for (int m = 0; m < 4; ++m) { const int pos = p0 + 4 * ai + m; const bool in = pos >= 0 && pos < 8192; const float sc = in ? rsqrtf(sp[in ? pos : 0] * (1.f / 1024.f) + MK_EPS) : 0.f;
#pragma unroll
                for (int bj = 0; bj < 2; ++bj)
#pragma unroll
                    for (int n = 0; n < 2; ++n)
#pragma unroll
                        for (int i = 0; i < 4; ++i) acc[ai][bj][m][n][i] = in ? acc[ai][bj][m][n][i] * sc : 0.f; } }
        asm volatile("" ::: "memory"); __builtin_amdgcn_sched_barrier(0);
#pragma unroll
        for (int n = 0; n < 2; ++n) {
            const int c4 = col + 4 * n;
            const f32x4 WG0 = *(const f32x4*)(cw + c4), WG1 = *(const f32x4*)(cw + 5632 + c4), WG2 = *(const f32x4*)(cw + 2 * 5632 + c4), BG = *(const f32x4*)(cb + c4),
                        WV0 = *(const f32x4*)(cw + 2816 + c4), WV1 = *(const f32x4*)(cw + 5632 + 2816 + c4), WV2 = *(const f32x4*)(cw + 2 * 5632 + 2816 + c4), BV = *(const f32x4*)(cb + 2816 + c4);
#pragma unroll
            for (int i = 0; i < 4; ++i) {
                const float wg0 = WG0[i], wg1 = WG1[i], wg2 = WG2[i], bg = BG[i], wv0 = WV0[i], wv1 = WV1[i], wv2 = WV2[i], bv = BV[i];
                float g[10], v[10];
#pragma unroll
                for (int k = 0; k < 8; ++k) { g[k + 1] = acc[k >> 2][0][k & 3][n][i]; v[k + 1] = acc[k >> 2][1][k & 3][n][i]; }
                g[0] = __int_as_float(__builtin_amdgcn_mov_dpp(__float_as_int(g[8]), 0x111, 0xf, 0xf, true)); v[0] = __int_as_float(__builtin_amdgcn_mov_dpp(__float_as_int(v[8]), 0x111, 0xf, 0xf, true));
                g[9] = __int_as_float(__builtin_amdgcn_mov_dpp(__float_as_int(g[1]), 0x101, 0xf, 0xf, true)); v[9] = __int_as_float(__builtin_amdgcn_mov_dpp(__float_as_int(v[1]), 0x101, 0xf, 0xf, true));
                float o[8];
#pragma unroll
                for (int k = 0; k < 8; ++k) { const float ug = wg0 * g[k] + wg1 * g[k + 1] + wg2 * g[k + 2] + bg, uv = wv0 * v[k] + wv1 * v[k + 1] + wv2 * v[k + 2] + bv;
                    o[k] = ug * __builtin_amdgcn_rcpf(1.f + __expf(-ug)) * uv; }
                asm volatile("" : "+v"(o[0]), "+v"(o[1]), "+v"(o[2]), "+v"(o[3]), "+v"(o[4]), "+v"(o[5]), "+v"(o[6]), "+v"(o[7]) :: "memory");
#pragma unroll
                for (int k = 0; k < 8; ++k) acc[k >> 2][0][k & 3][n][i] = o[k];
                __builtin_amdgcn_sched_barrier(0); } }
        { int p0l = p0, frl = fr; asm volatile("" : "+v"(p0l), "+v"(frl));
          bf16_t* rp = act + ((long)tokb + p0l) * 2816 + col;
#pragma unroll
          for (int k = 0; k < 8; ++k) { const int to = 8 * frl + k - 1, pos = p0l + k;
              if (to >= 0 && to < 126 && pos < 8192) *(u32x4*)(rp + k * 2816) = pack8(acc[k >> 2][0][k & 3][0], acc[k >> 2][0][k & 3][1]); } }
    }
};
struct EpiPle {
    static constexpr bool PERM = true, AFTER_DRAIN = false;
    float* h; const bf16_t* pr; int ldc; const float* ss2; const float* ssp; const float* gpost; float* ss3;
    __device__ __forceinline__ void operator()(const f32x4 (&acc)[2][2][4][2], const Unit& u, int wr, int wc, int fr, int fq) const {
        const int row0 = u.pm * BM + wr * 64 + fr, col0 = u.pn * BM + wc * 32 + 8 * fq;
        f32x4 g0[2], g1[2];
#pragma unroll
        for (int bj = 0; bj < 2; ++bj) { g0[bj] = *(const f32x4*)(gpost + col0 + bj * HALF); g1[bj] = *(const f32x4*)(gpost + col0 + bj * HALF + 4); }
#pragma unroll
        for (int ai = 0; ai < 2; ++ai)
#pragma unroll
            for (int m = 0; m < 4; ++m) { const int row = row0 + ai * HALF + m * 16; const size_t off = (size_t)row * ldc + col0; float s = 0.f;
                const float r2 = rsqrtf(ss2[row] * (1.f / 1024.f) + MK_EPS), rp = rsqrtf(ssp[row] * (1.f / 1024.f) + MK_EPS);
#pragma unroll
                for (int bj = 0; bj < 2; ++bj) { const f32x4 h0 = *(const f32x4*)(h + off + bj * HALF), h1 = *(const f32x4*)(h + off + bj * HALF + 4); const u32x4 pw = *(const u32x4*)(pr + off + bj * HALF);
                    const f32x4 p0 = (f32x4){bf_lo(pw.x), bf_hi(pw.x), bf_lo(pw.y), bf_hi(pw.y)} * rp * g0[bj], p1 = (f32x4){bf_lo(pw.z), bf_hi(pw.z), bf_lo(pw.w), bf_hi(pw.w)} * rp * g1[bj];
                    f32x4 a0 = acc[ai][bj][m][0] * r2, a1 = acc[ai][bj][m][1] * r2, v0, v1;
#pragma unroll
                    for (int i = 0; i < 4; ++i) { v0[i] = h0[i] + p0[i] / (1.f + __expf(-a0[i])); v1[i] = h1[i] + p1[i] / (1.f + __expf(-a1[i])); }
                    *(f32x4*)(h + off + bj * HALF) = v0; *(f32x4*)(h + off + bj * HALF + 4) = v1; s += sq4(v0) + sq4(v1); }
                if (ss3) { s = red_fq(s); if (fq == 0) unsafeAtomicAdd(ss3 + row, s); }
                if (m & 1) asm volatile("" ::: "memory"); }
    }
};
template <class Epi, class Sched, bool ALIGN_EPI = false, bool SP2 = false>
__device__ __forceinline__ void gemm_phase(PG8_LAS unsigned char* lds, const Gemm g, const Sched& S, const Epi& E) {
    const int tid = threadIdx.x, wid = __builtin_amdgcn_readfirstlane(tid >> 6), lane = tid & 63, wr = wid >> 2, wc = wid & 3, fr = lane & 15, fq = lane >> 4;
    const int K = g.K, nt = K / BK;
    unsigned voffA[2], voffB[2];
#pragma unroll
    for (int i = 0; i < 2; ++i) { int R, C; stage_rc(tid * 16 + i * 8192, R, C); const int Rb = Epi::PERM ? ((R & ~31) + perm32(R & 31)) : R;
        { const int Ra = g.amode ? ((R >> 6) * 126 + (R & 15) * 8 + ((R >> 4) & 3)) : R; voffA[i] = (unsigned)(Ra * g.lda + C) * 2u; } voffB[i] = (unsigned)(Rb * K + C) * 2u; }
    const size_t kstep = (size_t)(BK * 2);
    const size_t hstep = (size_t)HALF * K * 2;
    const size_t tstep = 2 * hstep; const size_t hstepA = (size_t)(g.amode ? 4 : HALF) * g.lda * 2, rowB = (size_t)g.lda * 2;
    const unsigned ldsw = (unsigned)wid * 1024u;
    const int aoff = lds_byte(wr * 64 + fr, fq * 8), boff = lds_byte(wc * 32 + fr, fq * 8);
#define PG8_SA(b, h) (((b) * 2 + (h)) * HTB)
#define PG8_SB(b, h) ((4 + (b) * 2 + (h)) * HTB)
#define PG8_STAGE(bufoff, gbase, voff) do { _Pragma("unroll") for (int _i = 0; _i < 2; ++_i) \
        __builtin_amdgcn_global_load_lds((const unsigned*)((const char*)(gbase) + (voff)[_i]), (PG8_LAS unsigned*)(lds + (bufoff) + ldsw + _i * 8192), 16, 0, 0); } while (0)
#define PG8_LDA(dst, b, h) do { _Pragma("unroll") for (int m = 0; m < 4; ++m) _Pragma("unroll") for (int k = 0; k < 2; ++k) dst[m][k] = *(const PG8_LAS bf16x8*)(lds + PG8_SA(b, h) + aoff + m * 2048 + k * 1024); } while (0)
#define PG8_LDB(dst, b, h) do { _Pragma("unroll") for (int n = 0; n < 2; ++n) _Pragma("unroll") for (int k = 0; k < 2; ++k) dst[n][k] = *(const PG8_LAS bf16x8*)(lds + PG8_SB(b, h) + boff + n * 2048 + k * 1024); } while (0)
#define PG8_MMA(ai, bj, At, Bt) do { __builtin_amdgcn_s_setprio(1); _Pragma("unroll") for (int m = 0; m < 4; ++m) _Pragma("unroll") for (int n = 0; n < 2; ++n) _Pragma("unroll") for (int k = 0; k < 2; ++k) \
        acc[ai][bj][m][n] = __builtin_amdgcn_mfma_f32_16x16x32_bf16(Bt[n][k], At[m][k], acc[ai][bj][m][n], 0, 0, 0); __builtin_amdgcn_s_setprio(0); } while (0)
#define PG8_WAIT_V(n) asm volatile("s_waitcnt vmcnt(" #n ")" ::: "memory")
#define PG8_WAIT_L(n) asm volatile("s_waitcnt lgkmcnt(" #n ")" ::: "memory")
#define PG8_BAR __builtin_amdgcn_s_barrier()
#define PG8_SCHED __builtin_amdgcn_sched_barrier(0)
    Unit cur, nxt; int ui = 0;
    if (!S.next(0, cur)) return;
    f32x4 acc[2][2][4][2];
#pragma unroll
    for (int a = 0; a < 2; ++a)
#pragma unroll
        for (int b = 0; b < 2; ++b)
#pragma unroll
            for (int m = 0; m < 4; ++m)
#pragma unroll
                for (int n = 0; n < 2; ++n) acc[a][b][m][n] = (f32x4){0.f, 0.f, 0.f, 0.f};
    bf16x8 At[4][2], B0[2][2], B1[2][2];
    const char* cA = (const char*)g.A + arow0(g, cur.pm) * rowB; const char* cB = (const char*)g.Bt + (size_t)cur.pn * tstep;
    S.a_ready(cur);
    if constexpr (SP2) {
        PG8_STAGE(PG8_SB(0, 0), cB, voffB); PG8_STAGE(PG8_SB(0, 1), cB + hstep, voffB); PG8_STAGE(PG8_SA(0, 0), cA, voffA); PG8_STAGE(PG8_SA(0, 1), cA + hstepA, voffA);
        if (wr == 1) PG8_BAR;
        PG8_WAIT_V(2); PG8_BAR;
        PG8_STAGE(PG8_SB(1, 0), cB + kstep, voffB); PG8_STAGE(PG8_SA(1, 0), cA + kstep, voffA); PG8_STAGE(PG8_SB(1, 1), cB + hstep + kstep, voffB);
        PG8_WAIT_V(6); PG8_BAR;
    } else {
        PG8_STAGE(PG8_SB(0, 0), cB, voffB); PG8_STAGE(PG8_SA(0, 0), cA, voffA); PG8_STAGE(PG8_SB(0, 1), cB + hstep, voffB); PG8_STAGE(PG8_SA(0, 1), cA + hstepA, voffA);
        if (wr == 1) PG8_BAR;
        PG8_WAIT_V(4); PG8_BAR;
        PG8_STAGE(PG8_SB(1, 0), cB + kstep, voffB); PG8_STAGE(PG8_SA(1, 0), cA + kstep, voffA); PG8_STAGE(PG8_SB(1, 1), cB + hstep + kstep, voffB);
        PG8_WAIT_V(6); PG8_BAR;
    }
    for (;;) {
        const bool has_next = S.next(ui + 1, nxt);
        const char* nA = has_next ? (const char*)g.A + arow0(g, nxt.pm) * rowB : cA; const char* nB = has_next ? (const char*)g.Bt + (size_t)nxt.pn * tstep : cB;
        for (int t = 0; t < nt; t += 2) {
            const bool last = (t == nt - 2);
            const char* a1 = cA + (size_t)(t + 1) * kstep;
            const char* a2 = last ? nA : cA + (size_t)(t + 2) * kstep; const char* b2 = last ? nB : cB + (size_t)(t + 2) * kstep;
            const char* a3 = a2 + kstep; const char* b3 = b2 + kstep;
            if (last && has_next) S.a_ready(nxt);
            if constexpr (SP2) {
            PG8_LDB(B0, 0, 0); PG8_LDB(B1, 0, 1); PG8_SCHED; PG8_LDA(At, 0, 0); PG8_STAGE(PG8_SA(1, 1), a1 + hstepA, voffA);
            PG8_WAIT_V(8); PG8_WAIT_L(0); PG8_BAR; PG8_MMA(0, 0, At, B0); PG8_MMA(0, 1, At, B1); PG8_BAR; PG8_SCHED;
            PG8_LDA(At, 0, 1); PG8_STAGE(PG8_SB(0, 0), b2, voffB); PG8_STAGE(PG8_SB(0, 1), b2 + hstep, voffB); PG8_STAGE(PG8_SA(0, 0), a2, voffA);
            PG8_WAIT_V(8); PG8_WAIT_L(0); PG8_BAR; PG8_MMA(1, 0, At, B0); PG8_MMA(1, 1, At, B1); PG8_BAR; PG8_SCHED;
            PG8_LDB(B0, 1, 0); PG8_LDB(B1, 1, 1); PG8_SCHED; PG8_LDA(At, 1, 0); PG8_STAGE(PG8_SA(0, 1), a2 + hstepA, voffA);
            PG8_WAIT_V(8); PG8_WAIT_L(0); PG8_BAR; PG8_MMA(0, 0, At, B0); PG8_MMA(0, 1, At, B1); PG8_BAR; PG8_SCHED;
            PG8_LDA(At, 1, 1); PG8_STAGE(PG8_SB(1, 0), b3, voffB); PG8_STAGE(PG8_SB(1, 1), b3 + hstep, voffB); PG8_STAGE(PG8_SA(1, 0), a3, voffA);
            PG8_WAIT_V(8); PG8_WAIT_L(0); PG8_BAR; PG8_MMA(1, 0, At, B0); PG8_MMA(1, 1, At, B1); PG8_BAR; PG8_SCHED;
            } else {
            PG8_LDB(B0, 0, 0); PG8_SCHED; PG8_LDA(At, 0, 0); PG8_STAGE(PG8_SA(1, 1), a1 + hstepA, voffA);
            PG8_WAIT_L(8); PG8_BAR; PG8_WAIT_L(0); PG8_MMA(0, 0, At, B0); PG8_BAR; PG8_SCHED;
            PG8_LDB(B1, 0, 1); PG8_STAGE(PG8_SB(0, 0), b2, voffB);
            PG8_BAR; PG8_WAIT_L(0); PG8_MMA(0, 1, At, B1); PG8_BAR;
            PG8_LDA(At, 0, 1); PG8_STAGE(PG8_SA(0, 0), a2, voffA);
            PG8_BAR; PG8_WAIT_L(0); PG8_MMA(1, 0, At, B0); PG8_BAR; PG8_SCHED;
            PG8_STAGE(PG8_SB(0, 1), b2 + hstep, voffB);
            PG8_WAIT_V(6); PG8_BAR; PG8_MMA(1, 1, At, B1); PG8_BAR;
            PG8_LDB(B0, 1, 0); PG8_SCHED; PG8_LDA(At, 1, 0); PG8_STAGE(PG8_SA(0, 1), a2 + hstepA, voffA);
            PG8_WAIT_L(8); PG8_BAR; PG8_WAIT_L(0); PG8_MMA(0, 0, At, B0); PG8_BAR; PG8_SCHED;
            PG8_LDB(B1, 1, 1); PG8_STAGE(PG8_SB(1, 0), b3, voffB);
            PG8_BAR; PG8_WAIT_L(0); PG8_MMA(0, 1, At, B1); PG8_BAR;
            PG8_LDA(At, 1, 1); PG8_STAGE(PG8_SA(1, 0), a3, voffA);
            PG8_BAR; PG8_WAIT_L(0); PG8_MMA(1, 0, At, B0); PG8_BAR; PG8_SCHED;
            PG8_STAGE(PG8_SB(1, 1), b3 + hstep, voffB);
            PG8_WAIT_V(6); PG8_BAR; PG8_MMA(1, 1, At, B1); PG8_BAR;
            }
        }
        if constexpr (ALIGN_EPI) { if (wr == 0) PG8_BAR; }
        if constexpr (!Epi::AFTER_DRAIN) { E(acc, cur, wr, wc, fr, fq); S.done(cur); }
        if (!has_next) break;
#pragma unroll
        for (int a = 0; a < 2; ++a)
#pragma unroll
            for (int b = 0; b < 2; ++b)
#pragma unroll
                for (int m = 0; m < 4; ++m)
#pragma unroll
                    for (int n = 0; n < 2; ++n) acc[a][b][m][n] = (f32x4){0.f, 0.f, 0.f, 0.f};
        cur = nxt; cA = nA; cB = nB; ++ui;
        if constexpr (ALIGN_EPI) { if (wr == 1) PG8_BAR; }
    }
    PG8_WAIT_V(0);
    if constexpr (!ALIGN_EPI) { if (wr == 0) PG8_BAR; }
    PG8_BAR;
    if constexpr (Epi::AFTER_DRAIN) { E.fused(acc, cur, wr, wc, fr, fq, lds, wid, lane); S.done(cur); }
#undef PG8_SA
#undef PG8_SB
#undef PG8_STAGE
#undef PG8_LDA
#undef PG8_LDB
#undef PG8_MMA
#undef PG8_WAIT_V
#undef PG8_WAIT_L
#undef PG8_BAR
#undef PG8_SCHED
}
}
namespace att {
using bf16 = __hip_bfloat16;
using bf16x8 = __attribute__((ext_vector_type(8))) short;
using s16x4  = __attribute__((ext_vector_type(4))) short;
using f32x16 = __attribute__((ext_vector_type(16))) float;
using f32x4  = __attribute__((ext_vector_type(4))) float;
using u32x4  = __attribute__((ext_vector_type(4))) unsigned;
constexpr int NW = 8, QBLK = 32, KVBLK = 64;
constexpr float SCALE = 0.07216878364870322f;
constexpr float THR = 8.f;
#ifndef ATT_SDEPTH
#define ATT_SDEPTH 1
#endif
constexpr int SDEPTH = ATT_SDEPTH;
#ifndef ATT_QLDS
#define ATT_QLDS 8
#endif
constexpr int QLDS = ATT_QLDS, QREG = 12 - QLDS;
constexpr int SHM_V = KVBLK * 128 * 2, SHM_K = KVBLK * 128 * 2, SHM_KR = KVBLK * 64 * 2;
constexpr int OFF_V = 0, OFF_K = 2 * SHM_V, OFF_KR = OFF_K + 2 * SHM_K, OFF_SCR = OFF_KR + 2 * SHM_KR, OFF_QL = OFF_SCR + NW * 64 * 4, SHM_ATTN = OFF_QL + NW * QLDS * 1024;
constexpr int LDQ = 768, LDKV = 1024, LDKR = 64, LDO = 1024;
#define KSWZ(row, colB) ((row) * 256 + ((colB) ^ (((row) & 7) << 4)))
#define KRSWZ(row, colB) ((row) * 128 + ((colB) ^ ((((row) >> 1) & 7) << 4)))
#define SBAR() __builtin_amdgcn_sched_barrier(0)
__device__ __forceinline__ int crow(int r, int hi) { return (r & 3) + 8 * (r >> 2) + 4 * hi; }
__device__ __forceinline__ unsigned cvtpk(float lo, float hi) { unsigned r; asm volatile("v_cvt_pk_bf16_f32 %0, %1, %2" : "=v"(r) : "v"(lo), "v"(hi)); return r; }
__device__ __forceinline__ bf16x8 ld8(const bf16* p) { return *reinterpret_cast<const bf16x8*>(p); }
__device__ __forceinline__ float bfv(short s) { return __uint_as_float(((unsigned)(unsigned short)s) << 16); }

__device__ __forceinline__ void partialSM(f32x16& p0, f32x16& p1, float& m_reg, float& mn, float& alpha) {
  constexpr float C = SCALE * 1.4426950408889634f;
  float pmax = p0[0]; for (int r = 1; r < 16; ++r) pmax = fmaxf(pmax, p0[r]); for (int r = 0; r < 16; ++r) pmax = fmaxf(pmax, p1[r]);
  { auto rr = __builtin_amdgcn_permlane32_swap(__float_as_uint(pmax), __float_as_uint(pmax), false, false);
    pmax = fmaxf(__uint_as_float(rr[0]), __uint_as_float(rr[1])); }
  if (__builtin_expect(__all(pmax - m_reg <= THR / SCALE), 1)) { mn = m_reg; alpha = 1.f; }
  else { mn = fmaxf(m_reg, pmax); alpha = __builtin_amdgcn_exp2f((m_reg - mn) * C); m_reg = mn; }
  float mnC = -mn * C;
  for (int r = 0; r < 16; ++r) p0[r] = fmaf(p0[r], C, mnC); for (int r = 0; r < 16; ++r) p1[r] = fmaf(p1[r], C, mnC);
  for (int r = 0; r < 16; ++r) p0[r] = __builtin_amdgcn_exp2f(p0[r]);
}
__device__ __forceinline__ void finishSM(f32x16& p0, f32x16& p1, float alpha, float& l_reg, bf16x8& pa0, bf16x8& pa1, bf16x8& pa2, bf16x8& pa3) {
  for (int r = 0; r < 16; ++r) p1[r] = __builtin_amdgcn_exp2f(p1[r]);
  float ps = 0; for (int r = 0; r < 16; ++r) ps += p0[r]; for (int r = 0; r < 16; ++r) ps += p1[r];
  { auto rr = __builtin_amdgcn_permlane32_swap(__float_as_uint(ps), __float_as_uint(ps), false, false);
    ps = __uint_as_float(rr[0]) + __uint_as_float(rr[1]); }
  l_reg = l_reg * alpha + ps;
#define PK4(P, BASE, OUT) do { unsigned a0 = cvtpk(P[BASE + 0], P[BASE + 1]), a1 = cvtpk(P[BASE + 2], P[BASE + 3]);   \
    unsigned b0 = cvtpk(P[BASE + 4], P[BASE + 5]), b1 = cvtpk(P[BASE + 6], P[BASE + 7]);                              \
    auto r0 = __builtin_amdgcn_permlane32_swap(a0, b0, false, false); auto r1 = __builtin_amdgcn_permlane32_swap(a1, b1, false, false); \
    u32x4 w = {r0[0], r1[0], r0[1], r1[1]}; OUT = *reinterpret_cast<bf16x8*>(&w); } while (0)
  PK4(p0, 0, pa0); PK4(p0, 8, pa1); PK4(p1, 0, pa2); PK4(p1, 8, pa3);
#undef PK4
}
__device__ __forceinline__ void qkt(f32x16& p0, f32x16& p1, const char* Ks, const char* Krs, const bf16x8* qr, const char* ql, int r32, int hi) {
#define QF(f) ((f) < QREG ? qr[(f) < QREG ? (f) : 0] : *reinterpret_cast<const bf16x8*>(ql + ((f) - QREG) * 1024))
  p0 = f32x16{}; p1 = f32x16{};
#pragma unroll
  for (int d0 = 0; d0 < 8; ++d0) { int cb = (d0 * 16 + hi * 8) * 2;
    bf16x8 b0 = *reinterpret_cast<const bf16x8*>(Ks + KSWZ(r32, cb));
    bf16x8 b1 = *reinterpret_cast<const bf16x8*>(Ks + KSWZ(32 + r32, cb));
    const bf16x8 qq = QF(d0);
    p0 = __builtin_amdgcn_mfma_f32_32x32x16_bf16(b0, qq, p0, 0, 0, 0);
    p1 = __builtin_amdgcn_mfma_f32_32x32x16_bf16(b1, qq, p1, 0, 0, 0); }
#pragma unroll
  for (int d0 = 0; d0 < 4; ++d0) { int cb = (d0 * 16 + hi * 8) * 2;
    bf16x8 b0 = *reinterpret_cast<const bf16x8*>(Krs + KRSWZ(r32, cb));
    bf16x8 b1 = *reinterpret_cast<const bf16x8*>(Krs + KRSWZ(32 + r32, cb));
    const bf16x8 qq = QF(8 + d0);
    p0 = __builtin_amdgcn_mfma_f32_32x32x16_bf16(b0, qq, p0, 0, 0, 0);
    p1 = __builtin_amdgcn_mfma_f32_32x32x16_bf16(b1, qq, p1, 0, 0, 0); }
#undef QF
}
__device__ __forceinline__ int v_st(int k, int c) { const int kk = (k & ~0xC) | ((k & 4) << 1) | ((k & 8) >> 1); return ((kk >> 3) * 4 + (c >> 5)) * 512 + ((kk & 7) * 32 + (c & 31)) * 2; }
__device__ __forceinline__ int v_rd_base(int lane) { return ((lane & 3) << 3) | (((lane >> 2) & 3) << 6) | (((lane >> 4) & 1) << 5) | (((lane >> 5) & 1) << 8); }
constexpr int v_rd_off(int d0, int ks, int half) { return d0 * 512 + ks * 4096 + half * 2048; }
template <int OFF> __device__ __forceinline__ s16x4 tr_read(int vb) {
  s16x4 r; asm volatile("ds_read_b64_tr_b16 %0, %1 offset:%2" : "=&v"(r) : "v"(vb), "i"(OFF) : "memory"); return r;
}
template <int D0> __device__ __forceinline__ void pv_one(f32x16& od, int vb, bf16x8 pa0, bf16x8 pa1, bf16x8 pa2, bf16x8 pa3) {
  const s16x4 l0 = tr_read<v_rd_off(D0, 0, 0)>(vb), h0 = tr_read<v_rd_off(D0, 0, 1)>(vb), l1 = tr_read<v_rd_off(D0, 1, 0)>(vb), h1 = tr_read<v_rd_off(D0, 1, 1)>(vb);
  const s16x4 l2 = tr_read<v_rd_off(D0, 2, 0)>(vb), h2 = tr_read<v_rd_off(D0, 2, 1)>(vb), l3 = tr_read<v_rd_off(D0, 3, 0)>(vb), h3 = tr_read<v_rd_off(D0, 3, 1)>(vb);
  asm volatile("s_waitcnt lgkmcnt(0)" ::: "memory"); SBAR();
#define PK(L, H) (bf16x8){L[0], L[1], L[2], L[3], H[0], H[1], H[2], H[3]}
  od = __builtin_amdgcn_mfma_f32_32x32x16_bf16(pa0, PK(l0, h0), od, 0, 0, 0);
  od = __builtin_amdgcn_mfma_f32_32x32x16_bf16(pa1, PK(l1, h1), od, 0, 0, 0);
  od = __builtin_amdgcn_mfma_f32_32x32x16_bf16(pa2, PK(l2, h2), od, 0, 0, 0);
  od = __builtin_amdgcn_mfma_f32_32x32x16_bf16(pa3, PK(l3, h3), od, 0, 0, 0);
#undef PK
}
__device__ __forceinline__ void pv_d0(f32x16* o, int vb, bf16x8 pa0, bf16x8 pa1, bf16x8 pa2, bf16x8 pa3) {
  pv_one<0>(o[0], vb, pa0, pa1, pa2, pa3); pv_one<1>(o[1], vb, pa0, pa1, pa2, pa3); pv_one<2>(o[2], vb, pa0, pa1, pa2, pa3); pv_one<3>(o[3], vb, pa0, pa1, pa2, pa3);
}
__device__ __forceinline__ void attn_unit(const bf16* __restrict__ Qb, const bf16* __restrict__ Kn, const bf16* __restrict__ Vh, const bf16* __restrict__ Kr,
                                          unsigned short* __restrict__ Ob, const float* __restrict__ costab, const float* __restrict__ sintab, int qpos0, int seq, char* lds) {
  const int tid = threadIdx.x, wid = tid >> 6, lane = tid & 63, r32 = lane & 31, hi = lane >> 5;
  char* V_lds = lds + OFF_V; char* K_lds = lds + OFF_K; char* KR_lds = lds + OFF_KR;
  float* ws = (float*)(lds + OFF_SCR) + wid * 64; float* li_l = ws; float* al_l = ws + 32;
  float m_reg = -1e30f, l_reg = 0; f32x16 o[4] = {}; bf16x8 qr[QREG > 0 ? QREG : 1]; char* ql = lds + OFF_QL + wid * (QLDS * 1024) + lane * 16;
#define QSET(f, v) do { if ((f) < QREG) qr[(f) < QREG ? (f) : 0] = (v); else *reinterpret_cast<bf16x8*>(ql + ((f) - QREG) * 1024) = (v); } while (0)
  const bf16* Qw = Qb + (long)(wid * QBLK + r32) * LDQ + hi * 8;
#pragma unroll
  for (int d0 = 0; d0 < 8; ++d0) QSET(d0, ld8(Qw + d0 * 16));
  { const int qp = qpos0 + wid * QBLK + r32;
#pragma unroll
    for (int d0 = 0; d0 < 2; ++d0) {
      const bf16x8 x1 = ld8(Qw + 128 + d0 * 16), x2 = ld8(Qw + 128 + 32 + d0 * 16);
      const float* cp = costab + (long)qp * 32 + d0 * 16 + hi * 8; const float* sp = sintab + (long)qp * 32 + d0 * 16 + hi * 8;
      const f32x4 c0 = *(const f32x4*)cp, c1 = *(const f32x4*)(cp + 4), s0 = *(const f32x4*)sp, s1 = *(const f32x4*)(sp + 4);
      float o1[8], o2[8];
#pragma unroll
      for (int j = 0; j < 8; ++j) { const float a = bfv(x1[j]), b = bfv(x2[j]), c = j < 4 ? c0[j] : c1[j - 4], s = j < 4 ? s0[j] : s1[j - 4]; o1[j] = a * c - b * s; o2[j] = b * c + a * s; }
      u32x4 w1 = {cvtpk(o1[0], o1[1]), cvtpk(o1[2], o1[3]), cvtpk(o1[4], o1[5]), cvtpk(o1[6], o1[7])};
      u32x4 w2 = {cvtpk(o2[0], o2[1]), cvtpk(o2[2], o2[3]), cvtpk(o2[4], o2[5]), cvtpk(o2[6], o2[7])};
      QSET(8 + d0, *reinterpret_cast<bf16x8*>(&w1)); QSET(10 + d0, *reinterpret_cast<bf16x8*>(&w2));
    } }
  const int sr = tid >> 4, sc = (tid & 15) * 8, vst0 = v_st(sr, sc), vst1 = v_st(32 + sr, sc);
  const int krow = tid >> 3, kcol = (tid & 7) * 8;
  const int vb0 = (int)(uintptr_t)V_lds + v_rd_base(lane);
  struct { bf16x8 vs0, vs1, ks0, ks1, kr0; } sr_[SDEPTH];
  const unsigned voff_kv = (unsigned)(sr * LDKV + sc) * 2u, voff_kr = (unsigned)(krow * LDKR + kcol) * 2u;
#define SLOAD(i, k0) do { const char* kt_ = (const char*)Kn + (size_t)(k0) * (LDKV * 2); const char* kt2_ = kt_ + 32 * LDKV * 2; const char* rt_ = (const char*)Kr + (size_t)(k0) * (LDKR * 2); \
    sr_[i].vs0 = *reinterpret_cast<const bf16x8*>(kt_ + voff_kv + 256); sr_[i].vs1 = *reinterpret_cast<const bf16x8*>(kt2_ + voff_kv + 256); \
    sr_[i].ks0 = *reinterpret_cast<const bf16x8*>(kt_ + voff_kv); sr_[i].ks1 = *reinterpret_cast<const bf16x8*>(kt2_ + voff_kv); \
    sr_[i].kr0 = *reinterpret_cast<const bf16x8*>(rt_ + voff_kr); } while (0)
#define SWRITE(b, i) do { *(bf16x8*)(V_lds + (b) * SHM_V + vst0) = sr_[i].vs0;          \
    *(bf16x8*)(V_lds + (b) * SHM_V + vst1) = sr_[i].vs1; int kc = sc * 2;               \
    *(bf16x8*)(K_lds + (b) * SHM_K + KSWZ(sr, kc)) = sr_[i].ks0;                       \
    *(bf16x8*)(K_lds + (b) * SHM_K + KSWZ(32 + sr, kc)) = sr_[i].ks1;                  \
    *(bf16x8*)(KR_lds + (b) * SHM_KR + KRSWZ(krow, kcol * 2)) = sr_[i].kr0; } while (0)
#define SWAIT() do { if constexpr (SDEPTH == 2) asm volatile("s_waitcnt vmcnt(5)" ::: "memory"); else asm volatile("s_waitcnt vmcnt(0)" ::: "memory"); } while (0)
#define RESC(a) do { if (__any((a) < 1.f)) { if (hi == 0) al_l[r32] = (a); asm volatile("s_waitcnt lgkmcnt(0)" ::: "memory"); \
    for (int d = 0; d < 4; ++d) for (int r = 0; r < 16; ++r) o[d][r] *= al_l[crow(r, hi)]; } } while (0)
  f32x16 pA0, pA1, pB0, pB1; float mnA, mnB, alA, alB; bf16x8 pa0, pa1, pa2, pa3; const int NT = seq / KVBLK;
  constexpr int SE = 0, SO = SDEPTH - 1;
  SLOAD(SE, 0); asm volatile("s_waitcnt vmcnt(0)" ::: "memory"); SWRITE(0, SE); __syncthreads();
  qkt(pA0, pA1, K_lds, KR_lds, qr, ql, r32, hi); partialSM(pA0, pA1, m_reg, mnA, alA);
  SLOAD(SO, KVBLK); if constexpr (SDEPTH == 2) { if (2 < NT) SLOAD(SE, 2 * KVBLK); }
  SWAIT(); SWRITE(1, SO); __syncthreads();
  for (int j = 1; j + 1 < NT; j += 2) {
    SBAR(); qkt(pB0, pB1, K_lds + SHM_K, KR_lds + SHM_KR, qr, ql, r32, hi);
    finishSM(pA0, pA1, alA, l_reg, pa0, pa1, pa2, pa3); SBAR();
    SLOAD(SO, (j + SDEPTH) * KVBLK); SBAR();
    pv_d0(o, vb0, pa0, pa1, pa2, pa3); partialSM(pB0, pB1, m_reg, mnB, alB);
    __syncthreads(); SWAIT(); SWRITE(0, SE);
    RESC(alB); __syncthreads();
    SBAR(); qkt(pA0, pA1, K_lds, KR_lds, qr, ql, r32, hi);
    finishSM(pB0, pB1, alB, l_reg, pa0, pa1, pa2, pa3); SBAR();
    if (SDEPTH == 1 || j + 3 < NT) SLOAD(SE, (j + 1 + SDEPTH) * KVBLK); SBAR();
    pv_d0(o, vb0 + (int)SHM_V, pa0, pa1, pa2, pa3); partialSM(pA0, pA1, m_reg, mnA, alA);
    __syncthreads(); SWAIT(); SWRITE(1, SO);
    RESC(alA); __syncthreads();
  }
  SBAR(); qkt(pB0, pB1, K_lds + SHM_K, KR_lds + SHM_KR, qr, ql, r32, hi);
  finishSM(pA0, pA1, alA, l_reg, pa0, pa1, pa2, pa3); SBAR();
  pv_d0(o, vb0, pa0, pa1, pa2, pa3); partialSM(pB0, pB1, m_reg, mnB, alB);
  __syncthreads(); RESC(alB);
  finishSM(pB0, pB1, alB, l_reg, pa0, pa1, pa2, pa3); SBAR();
  pv_d0(o, vb0 + (int)SHM_V, pa0, pa1, pa2, pa3);
  if (hi == 0) li_l[r32] = l_reg; asm volatile("s_waitcnt lgkmcnt(0)" ::: "memory");
  float rli[16];
#pragma unroll
  for (int r = 0; r < 16; ++r) rli[r] = __builtin_amdgcn_rcpf(li_l[crow(r, hi)]);
  __syncthreads();
  { int lx = lane, r32x = r32, hix = hi; asm volatile("" : "+v"(lx), "+v"(r32x), "+v"(hix));
    const int wx = __builtin_amdgcn_readfirstlane(wid);
    unsigned short* Ow = Ob + (long)(wx * QBLK) * LDO;
    char* ot = lds + wx * 8704;
    char* otw = ot + (4 * hix) * 272 + r32x * 2;
#pragma unroll
    for (int r = 0; r < 16; ++r) { const int orow0 = (r & 3) + 8 * (r >> 2);
#pragma unroll
      for (int d0 = 0; d0 < 4; ++d0) *reinterpret_cast<unsigned short*>(otw + orow0 * 272 + d0 * 64) = (unsigned short)(cvtpk(o[d0][r] * rli[r], 0.f) & 0xffffu); }
    asm volatile("s_waitcnt lgkmcnt(0)" ::: "memory");
    const char* otr = ot + (lx >> 4) * 272 + (lx & 15) * 16; unsigned short* owr = Ow + (long)(lx >> 4) * LDO + (lx & 15) * 8;
#pragma unroll
    for (int j = 0; j < 8; ++j) { const u32x4 v = *reinterpret_cast<const u32x4*>(otr + j * 4 * 272); *reinterpret_cast<u32x4*>(owr + (long)(j * 4) * LDO) = v; } }
  __syncthreads();
#undef QSET
#undef SLOAD
#undef SWRITE
#undef SWAIT
#undef RESC
}
#undef SBAR
}
#define LAS __attribute__((address_space(3)))
typedef unsigned short bf16_t;
typedef float f32x4 __attribute__((ext_vector_type(4)));
typedef float f32x2 __attribute__((ext_vector_type(2)));
typedef unsigned u32x4 __attribute__((ext_vector_type(4)));
typedef unsigned u32x2 __attribute__((ext_vector_type(2)));
typedef short bf16x8 __attribute__((ext_vector_type(8)));
typedef short s16x4 __attribute__((ext_vector_type(4)));
constexpr int NB = 8, SEQ = 8192, DM = 1024, MT = NB * SEQ;
constexpr int NPROJ = 2560, INCOLS = 2512, DFF = 2816, NUP = 2 * DFF, PLE = 256;
constexpr int HALF_ROWS = MT / 2;
constexpr size_t MiB = 1u << 20;
constexpr size_t WS_SS = 0;
constexpr size_t WS_BAR = 1792 * 1024;
constexpr size_t WS_WIN = 2 * MiB, WS_WUQ = WS_WIN + (size_t)NPROJ * DM * 2, WS_WUKV = WS_WUQ + 768 * 256 * 2, WS_WOUT = WS_WUKV + 1024 * 128 * 2,
                 WS_WUP = WS_WOUT + (size_t)DM * DM * 2, WS_WDN = WS_WUP + (size_t)NUP * DM * 2, WS_WG = WS_WDN + (size_t)DM * DFF * 2, WS_WP = WS_WG + (size_t)DM * DM * 2,
                 WS_WEND = WS_WP + (size_t)DM * PLE * 2;
static_assert(WS_WEND <= 30 * MiB, "weights");
constexpr size_t WS_COS = 30 * MiB, WS_SIN = 31 * MiB;
constexpr size_t WS_MSC = 34 * MiB;
constexpr size_t WS_PB = 58 * MiB;
constexpr size_t WS_PR = 90 * MiB;
constexpr size_t WS_HF = 90 * MiB, WS_HB = 154 * MiB;
constexpr size_t WS_XN = 218 * MiB;
constexpr size_t WS_PROJ = 346 * MiB;
constexpr size_t WS_H1B = 346 * MiB;
constexpr size_t WS_UP = 474 * MiB;
constexpr size_t WS_ACT = 826 * MiB;
constexpr size_t WS_QB = 666 * MiB, WS_KVB = 762 * MiB, WS_KR = 890 * MiB;
constexpr size_t WS_DS = 1002 * MiB;
constexpr size_t WS_END = 1004 * MiB;
constexpr int LDS_BYTES = 155648;
static_assert(att::SHM_ATTN <= LDS_BYTES && pg8::STAGE_BYTES <= LDS_BYTES, "LDS map");

__device__ __forceinline__ float bf2f(bf16_t b) { return __uint_as_float(((unsigned)b) << 16); }
__device__ __forceinline__ unsigned pk2(float lo, float hi) { return pg8::cvt_pk_bf16(lo, hi); }
__device__ __forceinline__ bf16_t f2bf(float f) { return (bf16_t)(pg8::cvt_pk_bf16(f, 0.f) & 0xffffu); }
__device__ __forceinline__ float wave_sum(float v) {
#pragma unroll
    for (int o = 1; o < 64; o <<= 1) v += __shfl_xor(v, o);
    return v;
}
__device__ __forceinline__ float siluf(float x) { return x * __builtin_amdgcn_rcpf(1.f + __expf(-x)); }
__device__ __forceinline__ float sigmf(float x) { return __builtin_amdgcn_rcpf(1.f + __expf(-x)); }
#define LDS_WAIT() asm volatile("s_waitcnt lgkmcnt(0)" ::: "memory")

__device__ __forceinline__ int map_in(int n) {
    if (n < 2048) return n;
    if (n < 2064) return 2496 + (n - 2048);
    if (n < 2320) return 2048 + (n - 2064);
    if (n < 2448) return 2304 + (n - 2320);
    return 2432 + (n - 2448);
}
__device__ __forceinline__ int map_up(int n) { const int c = n < 2816 ? n : n - 2816; return (c >> 7) * 256 + (n < 2816 ? 0 : 128) + (c & 127); }
template <int MAPIN>
__device__ __forceinline__ void tr_item(const float* W, int K, int N, const float* gk, bf16_t* WT, LAS float* scr, int item, int lane) {
    const int nblk = (N + 31) / 32, kb = item / nblk, nb = item % nblk, k0 = 64 * kb, n0 = 32 * nb;
    const int nn = n0 + (lane & 31);
#pragma unroll 8
    for (int i = 0; i < 32; ++i) { const int kk = 2 * i + (lane >> 5); float v = (nn < N) ? W[(size_t)(k0 + kk) * N + nn] : 0.f; if (gk) v *= gk[k0 + kk]; scr[kk * 33 + (lane & 31)] = v; }
    LDS_WAIT(); asm volatile("" ::: "memory");
    const int c = lane & 7;
#pragma unroll
    for (int j = 0; j < 4; ++j) { const int nl = (lane >> 3) + 8 * j, n = n0 + nl; const LAS float* s = scr + (8 * c) * 33 + nl;
        u32x4 o; o.x = pk2(s[0 * 33], s[1 * 33]); o.y = pk2(s[2 * 33], s[3 * 33]); o.z = pk2(s[4 * 33], s[5 * 33]); o.w = pk2(s[6 * 33], s[7 * 33]);
        if (n < N) { const int dst = MAPIN == 1 ? map_in(n) : (MAPIN == 2 ? map_up(n) : n); *(u32x4*)(WT + (size_t)dst * K + k0 + 8 * c) = o; } }
    LDS_WAIT(); asm volatile("" ::: "memory");
}
struct Args { const float* in[23]; float* out; unsigned char* ws; int ph_lo, ph_hi; };
typedef Args P;
enum { I_X = 0, I_P, I_LNMIX, I_WIN, I_BG, I_CQKW, I_CQKB, I_MNG, I_QNG, I_WUQ, I_KVNG, I_WUKV, I_WOUT, I_LNFFN, I_WUP, I_CFW, I_CFB, I_WDN, I_PLENG, I_WG, I_WP, I_PPOST, I_FINAL };

__device__ __forceinline__ void p0_prologue(const P& a, LAS unsigned char* lds, int G) {
    const int tid = threadIdx.x, lane = tid & 63, wave = tid >> 6;
    const int gw = blockIdx.x * 8 + wave, NGW = G * 8; const size_t gt = (size_t)blockIdx.x * 512 + tid, NGT = (size_t)G * 512;
    unsigned char* ws = a.ws;
    if (blockIdx.x == 0) { unsigned* bw = (unsigned*)(ws + WS_BAR); for (int i = tid; i < 3456; i += 512) bw[i] = 0u; }
    { float* ss = (float*)(ws + WS_SS); for (size_t i = gt; i < (size_t)6 * MT; i += NGT) ss[i] = 0.f;
      unsigned* pad = (unsigned*)(ws + WS_WIN + (size_t)INCOLS * DM * 2); for (size_t i = gt; i < (size_t)(NPROJ - INCOLS) * DM / 2; i += NGT) pad[i] = 0u; }
    LAS float* scr = (LAS float*)(lds + wave * 16384);
    constexpr int I0 = 16 * 79, I1 = 4 * 24, I2 = 2 * 32, I3 = 16 * 32, I4 = 16 * 176, I5 = 44 * 32, I6 = 16 * 32, I7 = 4 * 32;
    constexpr int NITEMS = I0 + I1 + I2 + I3 + I4 + I5 + I6 + I7;
    for (int it = gw; it < NITEMS; it += NGW) {
        int r = it;
        if (r < I0) { tr_item<1>(a.in[I_WIN], DM, INCOLS, nullptr, (bf16_t*)(ws + WS_WIN), scr, r, lane); continue; } r -= I0;
        if (r < I1) { tr_item<0>(a.in[I_WUQ], 256, 768, a.in[I_QNG], (bf16_t*)(ws + WS_WUQ), scr, r, lane); continue; } r -= I1;
        if (r < I2) { tr_item<0>(a.in[I_WUKV], 128, 1024, a.in[I_KVNG], (bf16_t*)(ws + WS_WUKV), scr, r, lane); continue; } r -= I2;
        if (r < I3) { tr_item<0>(a.in[I_WOUT], DM, DM, nullptr, (bf16_t*)(ws + WS_WOUT), scr, r, lane); continue; } r -= I3;
        if (r < I4) { tr_item<2>(a.in[I_WUP], DM, NUP, a.in[I_LNFFN], (bf16_t*)(ws + WS_WUP), scr, r, lane); continue; } r -= I4;
        if (r < I5) { tr_item<0>(a.in[I_WDN], DFF, DM, nullptr, (bf16_t*)(ws + WS_WDN), scr, r, lane); continue; } r -= I5;
        if (r < I6) { tr_item<0>(a.in[I_WG], DM, DM, a.in[I_PLENG], (bf16_t*)(ws + WS_WG), scr, r, lane); continue; } r -= I6;
        tr_item<0>(a.in[I_WP], PLE, DM, nullptr, (bf16_t*)(ws + WS_WP), scr, r, lane);
    }
    { const float* g = a.in[I_LNMIX]; f32x4 gv[4];
#pragma unroll
      for (int j = 0; j < 4; ++j) gv[j] = *((const f32x4*)g + lane + 64 * j);
      for (int m = gw; m < MT; m += NGW) { const f32x4* xr = (const f32x4*)(a.in[I_X] + (size_t)m * DM) + lane; f32x4 v[4]; float s = 0.f;
#pragma unroll
        for (int j = 0; j < 4; ++j) { v[j] = __builtin_nontemporal_load(xr + 64 * j); s += pg8::sq4(v[j]); }
        const float rstd = rsqrtf(wave_sum(s) * (1.f / DM) + MK_EPS);
        u32x2* o8 = (u32x2*)((bf16_t*)(ws + WS_XN) + (size_t)m * DM) + lane;
#pragma unroll
        for (int j = 0; j < 4; ++j) { const f32x4 y = v[j] * rstd * gv[j]; u32x2 w; w.x = pk2(y[0], y[1]); w.y = pk2(y[2], y[3]); o8[64 * j] = w; } } }
    { const f32x4* p4 = (const f32x4*)a.in[I_P]; u32x4* o = (u32x4*)(ws + WS_PB);
      for (size_t i = gt; i < (size_t)MT * PLE / 8; i += NGT) { const f32x4 v0 = __builtin_nontemporal_load(p4 + 2 * i), v1 = __builtin_nontemporal_load(p4 + 2 * i + 1); o[i] = pg8::pack8(v0, v1); } }
    { float* ct = (float*)(ws + WS_COS); float* st = (float*)(ws + WS_SIN);
      for (size_t i = gt; i < (size_t)SEQ * 32; i += NGT) { const int pos = (int)(i >> 5), c = (int)(i & 31);
        const float invf = powf(10000.f, -(float)(2 * c) / 64.f); const float ang = (float)pos * invf;
        const double ad = (double)ang; const double k = rint(ad * 0.15915494309189535); const float r = (float)(ad - k * 6.283185307179586);
        ct[i] = __cosf(r); st[i] = __sinf(r); } }
}
namespace ml {
constexpr int RS = 272;
constexpr int O_KS = 0, O_KT = 34816, O_VT = 69632, O_WVT = 78336, O_CS = 87040, O_VEC = 95744, O_CH = 99328, O_END = 100608;
constexpr int O_LF = 0, O_IP = 33024;
using f32x4 = ::f32x4;
__device__ __forceinline__ f32x4 mfma16(bf16x8 a, bf16x8 b, f32x4 c) { return __builtin_amdgcn_mfma_f32_16x16x32_bf16(a, b, c, 0, 0, 0); }
struct ConvW { f32x4 w[3][2]; f32x4 b[2]; };
__device__ __forceinline__ ConvW load_convw(const float* cw, const float* cb, int col) { ConvW c;
#pragma unroll
    for (int k = 0; k < 3; ++k) { c.w[k][0] = *(const f32x4*)(cw + k * 1024 + col); c.w[k][1] = *(const f32x4*)(cw + k * 1024 + col + 4); }
    c.b[0] = *(const f32x4*)(cb + col); c.b[1] = *(const f32x4*)(cb + col + 4); return c; }
__device__ __forceinline__ u32x4 conv8w(const u32x4 xm, const u32x4 x0, const u32x4 xp, const ConvW& c, float scale) {
    const unsigned m_[4] = {xm.x, xm.y, xm.z, xm.w}, c_[4] = {x0.x, x0.y, x0.z, x0.w}, p_[4] = {xp.x, xp.y, xp.z, xp.w}; unsigned o[4];
#pragma unroll
    for (int i = 0; i < 4; ++i) { const int hv = i >> 1, j = (2 * i) & 3;
        const float vl = pg8::bf_lo(m_[i]) * c.w[0][hv][j] + pg8::bf_lo(c_[i]) * c.w[1][hv][j] + pg8::bf_lo(p_[i]) * c.w[2][hv][j] + c.b[hv][j];
        const float vh = pg8::bf_hi(m_[i]) * c.w[0][hv][j + 1] + pg8::bf_hi(c_[i]) * c.w[1][hv][j + 1] + pg8::bf_hi(p_[i]) * c.w[2][hv][j + 1] + c.b[hv][j + 1];
        o[i] = pk2(siluf(vl) * scale, siluf(vh) * scale); }
    u32x4 w; w.x = o[0]; w.y = o[1]; w.z = o[2]; w.w = o[3]; return w;
}
__device__ __forceinline__ void qkv_prep_unit(LAS unsigned char* lds, int unit, const bf16_t* proj, const float* conv_w, const float* conv_b, const float* b_gates,
                                              bf16_t* Qc, bf16_t* KTg, bf16_t* VTg, bf16_t* hf, bf16_t* hb, float* dsg) {
    const int tid = threadIdx.x, wid = tid >> 6, lane = tid & 63, l15 = lane & 15, q4 = lane >> 4; const int b = unit >> 8, cp = (unit >> 2) & 63, h = unit & 3; const size_t tokb = (size_t)b * SEQ;
    constexpr int O_K = 0, O_V = 34816, O_Q = 69632, O_VTL = 104448, O_GV = 139264;
    LAS float* LFi = (LAS float*)(lds + O_GV); LAS float* IPi = LFi + 256; LAS float* U2 = LFi + 512; LAS float* PM2 = LFi + 768;
    const u32x4 z = {0u, 0u, 0u, 0u};
    if (tid < 256) { const int p = tid & 127, d = tid >> 7, pos = cp * 128 + p; const bf16_t* row = proj + (tokb + pos) * NPROJ + 2496; const int ci = (2 * d) * 4 + h, cf = (2 * d + 1) * 4 + h;
        const float ip = bf2f(row[ci]) + b_gates[ci], fp = bf2f(row[cf]) + b_gates[cf]; LFi[d * 128 + p] = fminf(fp, 0.f) - log1pf(__expf(-fabsf(fp))); IPi[d * 128 + p] = ip; }
    { const int e0 = (tid & 15) * 8; const ConvW cq = load_convw(conv_w, conv_b, h * 128 + e0), ck = load_convw(conv_w, conv_b, 512 + h * 128 + e0);
#pragma unroll
      for (int it = 0; it < 4; ++it) { const int i = tid + 512 * it, p = i >> 4, pos = cp * 128 + p; const bf16_t* rp = proj + (tokb + pos) * NPROJ + h * 128 + e0;
        { const u32x4 x0 = *(const u32x4*)rp, xm = pos > 0 ? *(const u32x4*)(rp - NPROJ) : z, xp = pos < SEQ - 1 ? *(const u32x4*)(rp + NPROJ) : z;
          const u32x4 w = conv8w(xm, x0, xp, cq, 1.f); *(u32x4*)(Qc + (tokb + pos) * 512 + h * 128 + e0) = w; *(LAS u32x4*)(lds + O_Q + p * RS + e0 * 2) = w; }
        { const bf16_t* rk = rp + 512; const u32x4 x0 = *(const u32x4*)rk, xm = pos > 0 ? *(const u32x4*)(rk - NPROJ) : z, xp = pos < SEQ - 1 ? *(const u32x4*)(rk + NPROJ) : z;
          *(LAS u32x4*)(lds + O_K + p * RS + e0 * 2) = conv8w(xm, x0, xp, ck, 0.08838834764831845f); }
        *(LAS u32x4*)(lds + O_V + p * RS + e0 * 2) = *(const u32x4*)(rp + 1024); } }
    __syncthreads();
    if (wid < 2) { const int d = wid, p0 = d ? 127 - 2 * lane : 2 * lane, p1 = d ? p0 - 1 : p0 + 1;
        const float lf0 = LFi[d * 128 + p0], lf1 = LFi[d * 128 + p1], i0 = IPi[d * 128 + p0], i1 = IPi[d * 128 + p1];
        float inc = lf0 + lf1;
#pragma unroll
        for (int o = 1; o < 64; o <<= 1) { const float t = __shfl_up(inc, o); if (lane >= o) inc += t; }
        const float g0 = inc - lf1, g1 = inc; const float u0 = i0 - g0, u1 = i1 - g1;
        float mx = fmaxf(u0, u1);
#pragma unroll
        for (int o = 1; o < 64; o <<= 1) { const float t = __shfl_up(mx, o); if (lane >= o) mx = fmaxf(mx, t); }
        float ex = __shfl_up(mx, 1); if (lane == 0) ex = -INFINITY;
        const float pm0 = fmaxf(ex, u0), pm1 = fmaxf(pm0, u1);
        U2[d * 128 + p0] = u0 * 1.4426950408889634f; U2[d * 128 + p1] = u1 * 1.4426950408889634f; PM2[d * 128 + p0] = pm0 * 1.4426950408889634f; PM2[d * 128 + p1] = pm1 * 1.4426950408889634f; }
#pragma unroll
    for (int it = 0; it < 4; ++it) { const int i = tid + 512 * it, e = i & 127, p0 = (i >> 7) * 8; unsigned short kv[8], vv[8];
#pragma unroll
        for (int j = 0; j < 8; ++j) { kv[j] = *(const LAS bf16_t*)(lds + O_K + (p0 + j) * RS + e * 2); vv[j] = *(const LAS bf16_t*)(lds + O_V + (p0 + j) * RS + e * 2); }
        u32x4 wk, wv; wk.x = kv[0] | ((unsigned)kv[1] << 16); wk.y = kv[2] | ((unsigned)kv[3] << 16); wk.z = kv[4] | ((unsigned)kv[5] << 16); wk.w = kv[6] | ((unsigned)kv[7] << 16);
        wv.x = vv[0] | ((unsigned)vv[1] << 16); wv.y = vv[2] | ((unsigned)vv[3] << 16); wv.z = vv[4] | ((unsigned)vv[5] << 16); wv.w = vv[6] | ((unsigned)vv[7] << 16);
        *(u32x4*)(KTg + (size_t)unit * 16384 + e * 128 + p0) = wk; *(u32x4*)(VTg + (size_t)unit * 16384 + e * 128 + p0) = wv; *(LAS u32x4*)(lds + O_VTL + e * RS + p0 * 2) = wv; }
    __syncthreads();
    bf16x8 qf[4];
#pragma unroll
    for (int kk = 0; kk < 4; ++kk) qf[kk] = *(const LAS bf16x8*)(lds + O_Q + (16 * wid + l15) * RS + (32 * kk + 8 * q4) * 2);
    f32x4 sa[8];
#pragma unroll
    for (int n = 0; n < 8; ++n) { sa[n] = (f32x4){0.f, 0.f, 0.f, 0.f};
#pragma unroll
        for (int kk = 0; kk < 4; ++kk) { const bf16x8 kf = *(const LAS bf16x8*)(lds + O_K + (16 * n + l15) * RS + (32 * kk + 8 * q4) * 2); sa[n] = mfma16(kf, qf[kk], sa[n]); }
        if ((n & 3) == 3) __builtin_amdgcn_sched_barrier(0); }
    __syncthreads();
    const int tl = wid * 16 + l15; const size_t tok0 = tokb + (size_t)cp * 128;
#pragma unroll
    for (int d = 0; d < 2; ++d) {
        const float pmt = PM2[d * 128 + tl]; float dsum = 0.f; f32x4 accP[8];
#pragma unroll
        for (int dt = 0; dt < 8; ++dt) accP[dt] = (f32x4){0.f, 0.f, 0.f, 0.f};
#pragma unroll
        for (int kk = 0; kk < 4; ++kk) { float pv[8];
#pragma unroll
            for (int hh = 0; hh < 2; ++hh) { const int n = 2 * kk + hh; const f32x4 u4 = *(const LAS f32x4*)(U2 + d * 128 + 16 * n + 4 * q4);
#pragma unroll
                for (int r = 0; r < 4; ++r) { const int s = 16 * n + 4 * q4 + r; const bool ok = d ? (s >= tl) : (s <= tl); const float p = ok ? sa[n][r] * __builtin_amdgcn_exp2f(u4[r] - pmt) : 0.f; pv[4 * hh + r] = p; dsum += p; } }
            u32x4 pw; pw.x = pk2(pv[0], pv[1]); pw.y = pk2(pv[2], pv[3]); pw.z = pk2(pv[4], pv[5]); pw.w = pk2(pv[6], pv[7]);
#pragma unroll
            for (int dt = 0; dt < 8; ++dt) { const LAS unsigned char* vp = lds + O_VTL + (16 * dt + l15) * RS + (32 * kk + 4 * q4) * 2;
                const u32x2 va = *(const LAS u32x2*)vp, vb = *(const LAS u32x2*)(vp + 32); u32x4 vw; vw.x = va.x; vw.y = va.y; vw.z = vb.x; vw.w = vb.y;
                accP[dt] = mfma16(*reinterpret_cast<bf16x8*>(&pw), *reinterpret_cast<bf16x8*>(&vw), accP[dt]); } }
        dsum += __shfl_xor(dsum, 16); dsum += __shfl_xor(dsum, 32);
        if (q4 == 0) dsg[((size_t)d * MT + tok0 + tl) * 4 + h] = dsum;
        { LAS unsigned char* nt = lds + O_K + wid * 4352;
#pragma unroll
          for (int dt = 0; dt < 8; ++dt)
#pragma unroll
              for (int r = 0; r < 4; ++r) *(LAS bf16_t*)(nt + (4 * q4 + r) * RS + (16 * dt + l15) * 2) = f2bf(accP[dt][r]);
          LDS_WAIT();
          bf16_t* hd = (d ? hb : hf) + (tok0 + wid * 16) * 512 + h * 128;
#pragma unroll
          for (int j = 0; j < 4; ++j) { const int c = j * 64 + lane, row = c >> 4, ch = c & 15; const u32x4 v = *(const LAS u32x4*)(nt + row * RS + ch * 16); *(u32x4*)(hd + (size_t)row * 512 + ch * 8) = v; } }
    }
    __syncthreads();
}
constexpr int N_KT = 0, N_VT = 69632, N_CS = 87040, N_VEC = 113152, N_CH = 121344, N_END = 122624;
__device__ __forceinline__ void mlstm_item(LAS unsigned char* lds, int item, const bf16_t* proj, const float* b_gates, float* msc_all,
                                           const bf16_t* Qc, const bf16_t* KTg, const bf16_t* VTg, bf16_t* hf, bf16_t* hb, const float* dsg, bf16_t* hfw, bf16_t* hbw) {
    const int tid = threadIdx.x, wid = tid >> 6, lane = tid & 63, l15 = lane & 15, q4 = lane >> 4;
    const int xcd = item & 7, slot = item >> 3, db = slot & 3, bhd = xcd * 8 + (slot >> 2), b = bhd >> 3, h = (bhd >> 1) & 3, dir = bhd & 1;
    float* mscG = msc_all + (size_t)item * 3 * SEQ; float* mscU = mscG + SEQ; float* mscPM = mscU + SEQ;
    LAS float* LF = (LAS float*)(lds + O_LF); LAS float* IP = (LAS float*)(lds + O_IP);
    LAS float* VEC = (LAS float*)(lds + N_VEC); LAS float* NV = VEC + 1024;
    LAS float* GL = (LAS float*)(lds + N_CH); LAS float* PML = GL + 64; LAS float* MPREV = GL + 128; LAS float* SOLD = GL + 192; LAS float* SNEW = GL + 256;
    const size_t tokb = (size_t)b * SEQ;
    __syncthreads();
    { const int ci = (2 * dir) * 4 + h, cf = (2 * dir + 1) * 4 + h; const float bi = b_gates[ci], bfv = b_gates[cf];
#pragma unroll 4
      for (int j = tid; j < SEQ; j += 512) { const int pos = dir ? SEQ - 1 - j : j; const bf16_t* row = proj + (tokb + pos) * NPROJ + 2496;
        const float ip = bf2f(row[ci]) + bi, fp = bf2f(row[cf]) + bfv; const float lf = fminf(fp, 0.f) - log1pf(__expf(-fabsf(fp)));
        LF[j + (j >> 7)] = lf; IP[j + (j >> 7)] = ip; } }
    __syncthreads();
    for (int c = wid; c < 64; c += 8) {
        const float lf0 = LF[c * 129 + 2 * lane], lf1 = LF[c * 129 + 2 * lane + 1], i0 = IP[c * 129 + 2 * lane], i1 = IP[c * 129 + 2 * lane + 1];
        float inc = lf0 + lf1;
#pragma unroll
        for (int o = 1; o < 64; o <<= 1) { const float t = __shfl_up(inc, o); if (lane >= o) inc += t; }
        const float g0 = inc - lf1, g1 = inc, u0 = i0 - g0, u1 = i1 - g1;
        float mx = fmaxf(u0, u1);
#pragma unroll
        for (int o = 1; o < 64; o <<= 1) { const float t = __shfl_up(mx, o); if (lane >= o) mx = fmaxf(mx, t); }
        float ex = __shfl_up(mx, 1); if (lane == 0) ex = -INFINITY;
        const float pm0 = fmaxf(ex, u0), pm1 = fmaxf(pm0, u1);
        const int j0 = c * 128 + 2 * lane, p0 = dir ? SEQ - 1 - j0 : j0, p1 = dir ? p0 - 1 : p0 + 1;
        mscG[p0] = g0; mscU[p0] = u0; mscPM[p0] = pm0; mscG[p1] = g1; mscU[p1] = u1; mscPM[p1] = pm1;
        if (lane == 63) { GL[c] = g1; PML[c] = pm1; } }
    __syncthreads();
    if (wid == 0) { const float gl = GL[lane], mloc = gl + PML[lane]; float A = gl, B = mloc;
#pragma unroll
        for (int o = 1; o < 64; o <<= 1) { const float pA = __shfl_up(A, o), pB = __shfl_up(B, o); if (lane >= o) { B = fmaxf(pB + A, B); A = pA + A; } }
        const float mnew = fmaxf(A, B);
        float mprev = __shfl_up(mnew, 1); if (lane == 0) mprev = 0.f;
        MPREV[lane] = mprev; SOLD[lane] = __expf(gl + mprev - mnew); SNEW[lane] = __expf(mloc - mnew); }
    __syncthreads();
    for (int i = tid; i < 2 * 48 * RS / 4; i += 512) ((LAS unsigned*)(lds + N_CS))[i] = 0u;
    if (tid < 128) NV[tid] = 0.f;
    f32x4 Creg[2] = {(f32x4){0.f, 0.f, 0.f, 0.f}, (f32x4){0.f, 0.f, 0.f, 0.f}};
    __threadfence_block();
    __syncthreads();
    bf16_t* hout = dir ? hb : hf; bf16_t* houtw = dir ? hbw : hfw; const float* dsd = dsg + (size_t)dir * MT * 4;
    u32x4 ktreg[4], vtreg, qreg[4]; float vu = 0.f, vpm = 0.f, vg = 0.f; unsigned short ni[2][4]; float dsi[4];
    const int sp = tid >> 4, se0 = (tid & 15) * 8;
    const unsigned voO = (unsigned)((wid * 16 + 4 * q4) * 512 + l15) * 2u, voD = (unsigned)((wid * 16 + 4 * q4) * 4) * 4u;
    const unsigned voT = (unsigned)(sp * 128 + se0) * 2u, voQ = (unsigned)((wid * 16 + l15) * 512 + 8 * q4) * 2u, voM = (unsigned)tid * 4u;
#define ML_PREFETCH(cc) do { const int cp_ = dir ? 63 - (cc) : (cc); const size_t unit_ = ((size_t)b * 64 + cp_) * 4 + h; const size_t t0_ = tokb + (size_t)cp_ * 128; \
        const char* tb_ = (const char*)(KTg + unit_ * 16384); const char* vb_ = (const char*)(VTg + unit_ * 16384 + (size_t)db * 32 * 128); const char* qb_ = (const char*)(Qc + t0_ * 512 + h * 128); \
        const char* hb_ = (const char*)(hout + t0_ * 512 + h * 128 + db * 32); const char* db_ = (const char*)(dsd + t0_ * 4 + h); \
        _Pragma("unroll") for (int it = 0; it < 4; ++it) { ktreg[it] = *(const u32x4*)(tb_ + it * 8192 + voT); } \
        vtreg = *(const u32x4*)(vb_ + voT); \
        _Pragma("unroll") for (int kk = 0; kk < 4; ++kk) qreg[kk] = *(const u32x4*)(qb_ + voQ + 64 * kk); \
        _Pragma("unroll") for (int r = 0; r < 4; ++r) { ni[0][r] = *(const unsigned short*)(hb_ + voO + r * 1024); ni[1][r] = *(const unsigned short*)(hb_ + voO + r * 1024 + 32); dsi[r] = *(const float*)(db_ + voD + r * 16); } \
        if (tid < 128) { vu = *(const float*)((const char*)(mscU + cp_ * 128) + voM); vpm = *(const float*)((const char*)(mscPM + cp_ * 128) + voM); vg = *(const float*)((const char*)(mscG + cp_ * 128) + voM); } } while (0)
#define ML_STAGE(cc, bf_) do { \
        _Pragma("unroll") for (int it = 0; it < 4; ++it) *(LAS u32x4*)(lds + N_KT + (bf_) * 34816 + (sp + 32 * it) * RS + se0 * 2) = ktreg[it]; \
        *(LAS u32x4*)(lds + N_VT + (bf_) * 8704 + sp * RS + se0 * 2) = vtreg; \
        if (tid < 128) { const float mp = MPREV[cc], Mt = fmaxf(vpm, mp); LAS float* V_ = VEC + (bf_) * 512 + tid; \
            V_[0] = __expf(vpm - Mt); V_[128] = __expf(mp - Mt); V_[256] = __expf(-(vg + Mt)); V_[384] = __expf(vu - PML[cc]); } } while (0)
    ML_PREFETCH(0);
    ML_STAGE(0, 0);
    bf16x8 qf[4]; float numI[2][4], dsI[4];
#pragma unroll
    for (int kk = 0; kk < 4; ++kk) qf[kk] = *reinterpret_cast<bf16x8*>(&qreg[kk]);
#pragma unroll
    for (int r = 0; r < 4; ++r) { numI[0][r] = bf2f(ni[0][r]); numI[1][r] = bf2f(ni[1][r]); dsI[r] = dsi[r]; }
    ML_PREFETCH(1);
    __syncthreads();
    for (int c = 0; c < 64; ++c) {
        const int cp = dir ? 63 - c : c, bufo = c & 1;
        int l15x = l15, q4x = q4; asm volatile("" : "+v"(l15x), "+v"(q4x));
        LAS unsigned char* KTb = lds + N_KT + bufo * 34816; LAS unsigned char* VTb = lds + N_VT + bufo * 8704; LAS unsigned char* CSr = lds + N_CS + bufo * 13056; LAS unsigned char* CSw = lds + N_CS + (bufo ^ 1) * 13056;
        LAS float* RT = VEC + bufo * 512; LAS float* INTER = RT + 128; LAS float* FLOOR = RT + 256; LAS float* Wv = RT + 384;
        f32x4 accY[3]; bf16x8 cfr[3][4]; float inr[4], rtr[4], flr[4];
#pragma unroll
        for (int dt = 0; dt < 3; ++dt)
#pragma unroll
            for (int kk = 0; kk < 4; ++kk) cfr[dt][kk] = *(const LAS bf16x8*)(CSr + (16 * dt + l15x) * RS + (32 * kk + 8 * q4x) * 2);
        { const f32x4 i4 = *(const LAS f32x4*)(INTER + wid * 16 + 4 * q4x), r4 = *(const LAS f32x4*)(RT + wid * 16 + 4 * q4x), f4 = *(const LAS f32x4*)(FLOOR + wid * 16 + 4 * q4x);
#pragma unroll
          for (int r = 0; r < 4; ++r) { inr[r] = i4[r]; rtr[r] = r4[r]; flr[r] = f4[r]; } }
        __builtin_amdgcn_sched_barrier(0);
#pragma unroll
        for (int dt = 0; dt < 3; ++dt) { accY[dt] = (f32x4){0.f, 0.f, 0.f, 0.f};
#pragma unroll
            for (int kk = 0; kk < 4; ++kk) accY[dt] = mfma16(qf[kk], cfr[dt][kk], accY[dt]); }
#pragma unroll
        for (int r = 0; r < 4; ++r) { const float nq = __shfl(accY[2][r], lane & 48); const float in = inr[r], rt = rtr[r];
            const float den = rt * dsI[r] + in * nq; const float sc = __builtin_amdgcn_rcpf(fmaxf(fabsf(den), flr[r]));
            bf16_t* op = (bf16_t*)((char*)(houtw + (tokb + (size_t)cp * 128) * 512 + h * 128 + db * 32) + voO + r * 1024);
            op[0] = f2bf((rt * numI[0][r] + in * accY[0][r]) * sc); op[16] = f2bf((rt * numI[1][r] + in * accY[1][r]) * sc); }
        { const float so = SOLD[c], sn = SNEW[c];
          f32x4 wq[4][2]; u32x4 vwr[2][4]; bf16x8 kfr[4];
#pragma unroll
          for (int kk = 0; kk < 4; ++kk) { wq[kk][0] = *(const LAS f32x4*)(Wv + 32 * kk + 8 * q4x); wq[kk][1] = *(const LAS f32x4*)(Wv + 32 * kk + 8 * q4x + 4);
              vwr[0][kk] = *(const LAS u32x4*)(VTb + l15x * RS + (32 * kk + 8 * q4x) * 2); vwr[1][kk] = *(const LAS u32x4*)(VTb + (16 + l15x) * RS + (32 * kk + 8 * q4x) * 2);
              kfr[kk] = *(const LAS bf16x8*)(KTb + (16 * wid + l15x) * RS + (32 * kk + 8 * q4x) * 2); }
          const float nvo = NV[16 * wid + l15x];
          __builtin_amdgcn_sched_barrier(0);
#pragma unroll
          for (int dt = 0; dt < 2; ++dt) { f32x4 ac = (f32x4){0.f, 0.f, 0.f, 0.f};
#pragma unroll
              for (int kk = 0; kk < 4; ++kk) { const u32x4 vw = vwr[dt][kk];
                  u32x4 aw; aw.x = pk2(pg8::bf_lo(vw.x) * wq[kk][0][0], pg8::bf_hi(vw.x) * wq[kk][0][1]); aw.y = pk2(pg8::bf_lo(vw.y) * wq[kk][0][2], pg8::bf_hi(vw.y) * wq[kk][0][3]);
                  aw.z = pk2(pg8::bf_lo(vw.z) * wq[kk][1][0], pg8::bf_hi(vw.z) * wq[kk][1][1]); aw.w = pk2(pg8::bf_lo(vw.w) * wq[kk][1][2], pg8::bf_hi(vw.w) * wq[kk][1][3]);
                  ac = mfma16(*reinterpret_cast<bf16x8*>(&aw), kfr[kk], ac); }
              Creg[dt] = Creg[dt] * so + ac * sn;
#pragma unroll
              for (int r = 0; r < 4; ++r) *(LAS bf16_t*)(CSw + (16 * dt + 4 * q4x + r) * RS + (16 * wid + l15x) * 2) = f2bf(Creg[dt][r]); }
          { f32x4 an = (f32x4){0.f, 0.f, 0.f, 0.f};
#pragma unroll
            for (int kk = 0; kk < 4; ++kk) { u32x4 aw = {0u, 0u, 0u, 0u};
                if (l15x == 0) { aw.x = pk2(wq[kk][0][0], wq[kk][0][1]); aw.y = pk2(wq[kk][0][2], wq[kk][0][3]); aw.z = pk2(wq[kk][1][0], wq[kk][1][1]); aw.w = pk2(wq[kk][1][2], wq[kk][1][3]); }
                an = mfma16(*reinterpret_cast<bf16x8*>(&aw), kfr[kk], an); }
            if (q4x == 0) { const float nn = nvo * so + an[0] * sn; NV[16 * wid + l15x] = nn; *(LAS bf16_t*)(CSw + 32 * RS + (16 * wid + l15x) * 2) = f2bf(nn); } } }
        if (c + 1 < 64) {
            ML_STAGE(c + 1, bufo ^ 1);
#pragma unroll
            for (int kk = 0; kk < 4; ++kk) qf[kk] = *reinterpret_cast<bf16x8*>(&qreg[kk]);
#pragma unroll
            for (int r = 0; r < 4; ++r) { numI[0][r] = bf2f(ni[0][r]); numI[1][r] = bf2f(ni[1][r]); dsI[r] = dsi[r]; }
            if (c + 2 < 64) ML_PREFETCH(c + 2);
        }
        __syncthreads();
    }
#undef ML_STAGE
#undef ML_PREFETCH
}
}
__device__ __forceinline__ void k_rope_phase(const P& a, int G) {
    const bf16_t* proj = (const bf16_t*)(a.ws + WS_PROJ); bf16_t* kr = (bf16_t*)(a.ws + WS_KR); const float* ct = (const float*)(a.ws + WS_COS); const float* st = (const float*)(a.ws + WS_SIN);
    for (size_t i = (size_t)blockIdx.x * 512 + threadIdx.x; i < (size_t)MT * 32; i += (size_t)G * 512) { const size_t tok = i >> 5; const int c = (int)(i & 31), pos = (int)(tok & (SEQ - 1));
        const float x1 = bf2f(proj[tok * NPROJ + 2432 + c]), x2 = bf2f(proj[tok * NPROJ + 2464 + c]), cs = ct[pos * 32 + c], sn = st[pos * 32 + c];
        kr[tok * 64 + c] = f2bf(x1 * cs - x2 * sn); kr[tok * 64 + 32 + c] = f2bf(x2 * cs + x1 * sn); }
}
__device__ __forceinline__ void combine_rows(const P& a, int G) {
    const int lane = threadIdx.x & 63, wv = threadIdx.x >> 6;
    const bf16_t* proj = (const bf16_t*)(a.ws + WS_PROJ); const bf16_t* hf = (const bf16_t*)(a.ws + WS_HF); const bf16_t* hb = (const bf16_t*)(a.ws + WS_HB); bf16_t* y = (bf16_t*)(a.ws + WS_XN);
    const f32x4 g0 = *(const f32x4*)(a.in[I_MNG] + lane * 8), g1 = *(const f32x4*)(a.in[I_MNG] + lane * 8 + 4);
    for (int pm = blockIdx.x; pm < MT / 256; pm += G)
    for (int m = pm * 256 + wv; m < pm * 256 + 256; m += 8) {
        const u32x4 f = *(const u32x4*)(hf + (size_t)m * 512 + lane * 8), bk = *(const u32x4*)(hb + (size_t)m * 512 + lane * 8), ow = *(const u32x4*)(proj + (size_t)m * NPROJ + 1536 + lane * 8);
        const unsigned f_[4] = {f.x, f.y, f.z, f.w}, b_[4] = {bk.x, bk.y, bk.z, bk.w}, o_[4] = {ow.x, ow.y, ow.z, ow.w};
        float v[8]; float s = 0.f;
#pragma unroll
        for (int i = 0; i < 4; ++i) { v[2 * i] = pg8::bf_lo(f_[i]) + pg8::bf_lo(b_[i]); v[2 * i + 1] = pg8::bf_hi(f_[i]) + pg8::bf_hi(b_[i]); s += v[2 * i] * v[2 * i] + v[2 * i + 1] * v[2 * i + 1]; }
        s += __shfl_xor(s, 1); s += __shfl_xor(s, 2); s += __shfl_xor(s, 4); s += __shfl_xor(s, 8);
        const float rstd = rsqrtf(s * (1.f / 128.f) + MK_EPS);
        float r[8];
#pragma unroll
        for (int i = 0; i < 4; ++i) { r[2 * i] = v[2 * i] * rstd * (i < 2 ? g0[2 * i] : g1[2 * i - 4]) * sigmf(pg8::bf_lo(o_[i])); r[2 * i + 1] = v[2 * i + 1] * rstd * (i < 2 ? g0[2 * i + 1] : g1[2 * i - 3]) * sigmf(pg8::bf_hi(o_[i])); }
        u32x4 w; w.x = pk2(r[0], r[1]); w.y = pk2(r[2], r[3]); w.z = pk2(r[4], r[5]); w.w = pk2(r[6], r[7]);
        *(u32x4*)(y + (size_t)m * 1024 + lane * 8) = w;
    }
}
__device__ __forceinline__ void ffn_conv_phase(const P& a, int G, int bid) {
    const bf16_t* up = (const bf16_t*)(a.ws + WS_UP); bf16_t* act = (bf16_t*)(a.ws + WS_ACT); const float* cw = a.in[I_CFW]; const float* cb = a.in[I_CFB];
    constexpr int NCC = DFF / 8, RUN = 16; const size_t NIT = (size_t)(HALF_ROWS / RUN) * NCC;
    for (size_t id = (size_t)bid * 512 + threadIdx.x; id < NIT; id += (size_t)G * 512) {
        const int cc = (int)(id % NCC), run = (int)(id / NCC), r0 = run * RUN, t0 = r0 & (SEQ - 1), c0 = cc * 8;
        float wg[3][8], wv[3][8], bg[8], bv[8];
#pragma unroll
        for (int k = 0; k < 3; ++k)
#pragma unroll
            for (int j = 0; j < 8; ++j) { wg[k][j] = cw[k * NUP + c0 + j]; wv[k][j] = cw[k * NUP + DFF + c0 + j]; }
#pragma unroll
        for (int j = 0; j < 8; ++j) { bg[j] = cb[c0 + j]; bv[j] = cb[DFF + c0 + j]; }
        const u32x4 z = {0u, 0u, 0u, 0u};
        u32x4 gm = t0 > 0 ? *(const u32x4*)(up + (size_t)(r0 - 1) * NUP + c0) : z, vm = t0 > 0 ? *(const u32x4*)(up + (size_t)(r0 - 1) * NUP + DFF + c0) : z;
        u32x4 g0 = *(const u32x4*)(up + (size_t)r0 * NUP + c0), v0 = *(const u32x4*)(up + (size_t)r0 * NUP + DFF + c0);
#pragma unroll 4
        for (int i = 0; i < RUN; ++i) { const bool has = (t0 + i + 1) < SEQ;
            const u32x4 gp = has ? *(const u32x4*)(up + (size_t)(r0 + i + 1) * NUP + c0) : z, vp = has ? *(const u32x4*)(up + (size_t)(r0 + i + 1) * NUP + DFF + c0) : z;
            const unsigned gm_[4] = {gm.x, gm.y, gm.z, gm.w}, g0_[4] = {g0.x, g0.y, g0.z, g0.w}, gp_[4] = {gp.x, gp.y, gp.z, gp.w}, vm_[4] = {vm.x, vm.y, vm.z, vm.w}, v0_[4] = {v0.x, v0.y, v0.z, v0.w}, vp_[4] = {vp.x, vp.y, vp.z, vp.w};
            float o[8];
#pragma unroll
            for (int k = 0; k < 4; ++k) {
                const float gl = pg8::bf_lo(gm_[k]) * wg[0][2 * k] + pg8::bf_lo(g0_[k]) * wg[1][2 * k] + pg8::bf_lo(gp_[k]) * wg[2][2 * k] + bg[2 * k];
                const float gh = pg8::bf_hi(gm_[k]) * wg[0][2 * k + 1] + pg8::bf_hi(g0_[k]) * wg[1][2 * k + 1] + pg8::bf_hi(gp_[k]) * wg[2][2 * k + 1] + bg[2 * k + 1];
                const float vl = pg8::bf_lo(vm_[k]) * wv[0][2 * k] + pg8::bf_lo(v0_[k]) * wv[1][2 * k] + pg8::bf_lo(vp_[k]) * wv[2][2 * k] + bv[2 * k];
                const float vh = pg8::bf_hi(vm_[k]) * wv[0][2 * k + 1] + pg8::bf_hi(v0_[k]) * wv[1][2 * k + 1] + pg8::bf_hi(vp_[k]) * wv[2][2 * k + 1] + bv[2 * k + 1];
                o[2 * k] = siluf(gl) * vl; o[2 * k + 1] = siluf(gh) * vh; }
            u32x4 w; w.x = pk2(o[0], o[1]); w.y = pk2(o[2], o[3]); w.z = pk2(o[4], o[5]); w.w = pk2(o[6], o[7]);
            *(u32x4*)(act + (size_t)(r0 + i) * DFF + c0) = w;
            gm = g0; vm = v0; g0 = gp; v0 = vp; }
    }
}
__device__ __forceinline__ void final_norm_phase(const P& a, int G) {
    const int lane = threadIdx.x & 63, gw = blockIdx.x * 8 + (threadIdx.x >> 6), NGW = G * 8; const float* ss3 = (const float*)(a.ws + WS_SS) + (size_t)5 * MT;
    f32x4 gv[4];
#pragma unroll
    for (int j = 0; j < 4; ++j) gv[j] = *((const f32x4*)a.in[I_FINAL] + lane + 64 * j);
    for (int m = gw; m < MT; m += NGW) { f32x4* xr = (f32x4*)(a.out + (size_t)m * DM) + lane; const float rstd = rsqrtf(ss3[m] * (1.f / DM) + MK_EPS);
#pragma unroll
        for (int j = 0; j < 4; ++j) xr[64 * j] = xr[64 * j] * rstd * gv[j]; }
}

typedef unsigned long long gu64_unused_t;
#define XB_TMO      128
#define XB_XCNT(j)  (256  + 64 * (j))
#define XB_XSUB(j)  (1280 + 64 * (j))
#define XB_XGEN(j)  (2304 + 64 * (j))
#define XB_TOP      3328
#define XB_TOPGEN   3392
#define XCD_BAR_WORDS 3456
#define XB_SPIN_CAP (1u << 18)

__device__ __forceinline__ unsigned xb_ld(unsigned* p)              { return __hip_atomic_load(p, __ATOMIC_RELAXED, __HIP_MEMORY_SCOPE_AGENT); }
__device__ __forceinline__ unsigned xb_add(unsigned* p, unsigned v) { return __hip_atomic_fetch_add(p, v, __ATOMIC_RELAXED, __HIP_MEMORY_SCOPE_AGENT); }
__device__ __forceinline__ unsigned xb_xcc_id() { return (unsigned)__builtin_amdgcn_s_getreg((3 << 11) | 20) & 0xFu; }
#define XB_SPIN(cond, bar) do { unsigned _sp = 0; while (cond) { __builtin_amdgcn_s_sleep(1); \
    if ((++_sp & 255u) == 0u) { if (xb_ld(&(bar)[XB_TMO])) break; if (_sp > XB_SPIN_CAP) { atomicAdd(&(bar)[XB_TMO], 1u); break; } } } } while (0)

struct XcdBarrier {
    unsigned* bar; unsigned x;
    volatile LAS unsigned* st;
};

__device__ __forceinline__ XcdBarrier xcd_barrier_post(unsigned* bar, volatile LAS unsigned* st) {
    XcdBarrier b; b.bar = bar; b.x = xb_xcc_id(); b.st = st;
    if (threadIdx.x == 0) (void)xb_add(&bar[XB_XCNT(b.x)], 1u);
    return b;
}
__device__ __forceinline__ void xcd_barrier_complete(unsigned* bar, unsigned x, unsigned& nloc, unsigned& nx) {
    const unsigned G = gridDim.x * gridDim.y * gridDim.z;
    unsigned sum, cnt, mine, sp = 0u;
    for (;;) {
        sum = 0u; cnt = 0u; mine = 0u;
#pragma unroll
        for (unsigned j = 0; j < 16; ++j) { const unsigned c = xb_ld(&bar[XB_XCNT(j)]); sum += c; cnt += (c > 0u) ? 1u : 0u; mine = (j == x) ? c : mine; }
        if (sum == G) break;
        __builtin_amdgcn_s_sleep(1);
        if ((++sp & 255u) == 0u) { if (xb_ld(&bar[XB_TMO])) break; if (sp > XB_SPIN_CAP) { atomicAdd(&bar[XB_TMO], 1u); break; } }
    }
    nloc = mine > 0u ? mine : 1u; nx = cnt > 0u ? cnt : 1u;
}

__device__ __forceinline__ void xcd_barrier(const XcdBarrier& b) {
    asm volatile("s_waitcnt vmcnt(0)" ::: "memory");
    __syncthreads();
    if (threadIdx.x == 0) {
        unsigned* bar = b.bar;
        __builtin_amdgcn_s_waitcnt(0);
        unsigned nloc = b.st[0], nx = b.st[1];
        if (nloc == 0u) { xcd_barrier_complete(bar, b.x, nloc, nx); b.st[0] = nloc; b.st[1] = nx; }
        const unsigned old = xb_add(&bar[XB_XSUB(b.x)], 1u);
        const unsigned gen = old / nloc;
        if (old + 1u == (gen + 1u) * nloc) {
            __builtin_amdgcn_fence(__ATOMIC_RELEASE, "agent");
            asm volatile("s_waitcnt vmcnt(0)" ::: "memory");
            const unsigned og = xb_add(&bar[XB_TOP], 1u);
            const unsigned tg = og / nx;
            if (og + 1u == (tg + 1u) * nx) xb_add(&bar[XB_TOPGEN], 1u);
            else XB_SPIN(xb_ld(&bar[XB_TOPGEN]) == tg, bar);
            __builtin_amdgcn_fence(__ATOMIC_ACQUIRE, "agent");
            xb_add(&bar[XB_XGEN(b.x)], 1u);
            asm volatile("s_waitcnt vmcnt(0)" ::: "memory");
        } else {
            XB_SPIN(xb_ld(&bar[XB_XGEN(b.x)]) == gen, bar);
            __builtin_amdgcn_fence(__ATOMIC_ACQUIRE, "agent");
            asm volatile("s_waitcnt vmcnt(0)" ::: "memory");
        }
    }
    __syncthreads();
}


constexpr int NPH = 8;
__global__ void __launch_bounds__(512, 2) mega_fwd(Args args) {
    extern __shared__ __attribute__((aligned(16))) unsigned char lds_raw[];
    LAS unsigned char* lds = (LAS unsigned char*)lds_raw;
    const Args& a = args;
    const int G = gridDim.x, lo = args.ph_lo, hi = args.ph_hi;
    volatile LAS unsigned* bst = (volatile LAS unsigned*)(lds + LDS_BYTES - 16);
    if (threadIdx.x < 4) bst[threadIdx.x] = 0u;
    __syncthreads();
    unsigned* barw = (unsigned*)(args.ws + WS_BAR);
    XcdBarrier xb; xb.bar = barw; xb.x = 0; xb.st = bst;
    unsigned char* ws = args.ws;
    float* ssq = (float*)(ws + WS_SS); float* sskv = ssq + MT; float* ss1 = ssq + 2 * (size_t)MT; float* ss2 = ssq + 3 * (size_t)MT; float* ssp = ssq + 4 * (size_t)MT; float* ss3 = ssq + 5 * (size_t)MT;
#ifdef ONLY_PH
#define IN(k) ((k) == ONLY_PH)
#else
#define IN(k) (lo <= (k) && (k) < hi)
#endif
#if MK_N_LAUNCHES == 1
#define SEAM(k) do { if (IN(k) && IN((k) + 1)) { if ((k) == 0) { cg::this_grid().sync(); xb = xcd_barrier_post(barw, bst); } else xcd_barrier(xb); } } while (0)
#else
#define SEAM(k) do { } while (0)
#endif
    if (MK_REP_SYNC > 1) { for (int i = 0; i < 12; ++i) cg::this_grid().sync(); }
    if (IN(0)) { p0_prologue(a, lds, G); if (MK_REP_SMALL > 1) { __syncthreads(); int Gl = G; asm volatile("" : "+s"(Gl)); p0_prologue(a, lds, Gl); } } SEAM(0);
    if (IN(1)) {
        pg8::Gemm g{(const bf16_t*)(ws + WS_XN), (const bf16_t*)(ws + WS_WIN), MT, NPROJ, DM, DM, 0}; pg8::StaticOrder S; S.init(MT, NPROJ, G, (int)blockIdx.x);
        pg8::EpiProj E{(bf16_t*)(ws + WS_PROJ), NPROJ, ssq, sskv};
        pg8::gemm_phase<pg8::EpiProj, pg8::StaticOrder, true, true>(lds, g, S, E);
    } SEAM(1);
    if (IN(2)) {
        { pg8::Gemm g{(const bf16_t*)(ws + WS_PROJ) + 2048, (const bf16_t*)(ws + WS_WUQ), MT, 768, 256, NPROJ, 0}; pg8::StaticOrder S; S.init(MT, 768, G, (int)blockIdx.x);
          pg8::EpiScale E{(bf16_t*)(ws + WS_QB), 768, ssq, 1.f / 256.f, nullptr};
          pg8::gemm_phase<pg8::EpiScale, pg8::StaticOrder, true, true>(lds, g, S, E); }
        { pg8::Gemm g{(const bf16_t*)(ws + WS_PROJ) + 2304, (const bf16_t*)(ws + WS_WUKV), MT, 1024, 128, NPROJ, 0}; pg8::StaticOrder S; S.init(MT, 1024, G, (int)blockIdx.x);
          pg8::EpiScale E{(bf16_t*)(ws + WS_KVB), 1024, sskv, 1.f / 128.f, nullptr};
          pg8::gemm_phase<pg8::EpiScale, pg8::StaticOrder, true, true>(lds, g, S, E); }
        k_rope_phase(a, G);
        __syncthreads();
        for (int rep = 0; rep < MK_REP_P2; ++rep)
        for (int u = blockIdx.x; u < 2048; u += G)
            ml::qkv_prep_unit(lds, u, (const bf16_t*)(ws + WS_PROJ), a.in[I_CQKW], a.in[I_CQKB], a.in[I_BG], (bf16_t*)a.out, (bf16_t*)a.out + (size_t)MT * 1024, (bf16_t*)a.out + (size_t)MT * 1536,
                              (bf16_t*)(ws + WS_HF), (bf16_t*)(ws + WS_HB), (float*)(ws + WS_DS));
    } SEAM(2);
    if (IN(3)) {
#ifndef SKIP_ML
        if (MK_REP_ML > 1) { int Gl = G; asm volatile("" : "+s"(Gl));
            for (int it = blockIdx.x; it < 256; it += Gl)
                ml::mlstm_item(lds, it, (const bf16_t*)(ws + WS_PROJ), a.in[I_BG], (float*)(ws + WS_MSC), (const bf16_t*)a.out, (const bf16_t*)a.out + (size_t)MT * 1024,
                               (const bf16_t*)a.out + (size_t)MT * 1536, (bf16_t*)(ws + WS_HF), (bf16_t*)(ws + WS_HB), (const float*)(ws + WS_DS), (bf16_t*)(ws + 898 * MiB), (bf16_t*)(ws + 898 * MiB)); }
        for (int it = blockIdx.x; it < 256; it += G)
            ml::mlstm_item(lds, it, (const bf16_t*)(ws + WS_PROJ), a.in[I_BG], (float*)(ws + WS_MSC), (const bf16_t*)a.out, (const bf16_t*)a.out + (size_t)MT * 1024,
                           (const bf16_t*)a.out + (size_t)MT * 1536, (bf16_t*)(ws + WS_HF), (bf16_t*)(ws + WS_HB), (const float*)(ws + WS_DS), (bf16_t*)(ws + WS_HF), (bf16_t*)(ws + WS_HB));
#endif
        __syncthreads();
#ifndef SKIP_ATT
        for (int rep = 0; rep < MK_REP_ATT; ++rep)
        for (int it = blockIdx.x; it < 1024; it += G) {
            int bh, qb; if (G == 256) { bh = (it >> 8) * 8 + (it & 7); qb = (it & 255) >> 3; } else { bh = it >> 5; qb = it & 31; }
            const int b = bh >> 2, h = bh & 3; const size_t tokb = (size_t)b * SEQ;
            const att::bf16* Q = (const att::bf16*)(ws + WS_QB) + (tokb + (size_t)qb * 256) * 768 + h * 192;
            const att::bf16* Kn = (const att::bf16*)(ws + WS_KVB) + tokb * 1024 + h * 256; const att::bf16* Vh = Kn + 128;
            const att::bf16* Kr = (const att::bf16*)(ws + WS_KR) + tokb * 64;
            unsigned short* O = (unsigned short*)(ws + WS_XN) + (tokb + (size_t)qb * 256) * 1024 + 512 + h * 128;
            att::attn_unit(Q, Kn, Vh, Kr, O, (const float*)(ws + WS_COS), (const float*)(ws + WS_SIN), qb * 256, SEQ, (char*)lds_raw);
        }
#endif
    } SEAM(3);
    if (IN(4)) {
        combine_rows(a, G);
        asm volatile("s_waitcnt vmcnt(0)" ::: "memory"); __syncthreads(); __builtin_amdgcn_fence(__ATOMIC_ACQUIRE, "agent"); asm volatile("s_waitcnt vmcnt(0)" ::: "memory"); __syncthreads();
        { pg8::Gemm g{(const bf16_t*)(ws + WS_XN), (const bf16_t*)(ws + WS_WOUT), MT, DM, DM, DM, 0}; pg8::PanelOrder S{(int)blockIdx.x, G, MT / 256};
          pg8::EpiResid E{a.in[I_X], a.out, (bf16_t*)(ws + WS_H1B), DM, ss1};
          pg8::gemm_phase<pg8::EpiResid, pg8::PanelOrder, true, true>(lds, g, S, E); }
        { pg8::Gemm g{(const bf16_t*)(ws + WS_PB), (const bf16_t*)(ws + WS_WP), MT, DM, PLE, PLE, 0}; pg8::StaticOrder S; S.init(MT, DM, G, (int)blockIdx.x);
          pg8::EpiScale E{(bf16_t*)(ws + WS_PR), DM, nullptr, 0.f, ssp};
          pg8::gemm_phase<pg8::EpiScale, pg8::StaticOrder, true, true>(lds, g, S, E); }
    } SEAM(4);
    if (IN(5)) {
        pg8::Gemm g{(const bf16_t*)(ws + WS_H1B) - DM, (const bf16_t*)(ws + WS_WUP), 264 * 256, NUP, DM, DM, 1}; pg8::StaticOrder S; S.init(264 * 256, NUP, G, (int)blockIdx.x);
        pg8::EpiConvAct E{(bf16_t*)(ws + WS_UP), ss1, a.in[I_CFW], a.in[I_CFB]};
        pg8::gemm_phase<pg8::EpiConvAct, pg8::StaticOrder, true, true>(lds, g, S, E);
        if (MK_REP_UP > 1) { __syncthreads(); pg8::gemm_phase<pg8::EpiConvAct, pg8::StaticOrder, true, true>(lds, g, S, E); }
    } SEAM(5);
    if (IN(6)) {
        pg8::Gemm g{(const bf16_t*)(ws + WS_UP), (const bf16_t*)(ws + WS_WDN), MT, DM, DFF, DFF, 0}; pg8::StaticOrder S; S.init(MT, DM, G, (int)blockIdx.x);
        pg8::EpiResid E{a.out, a.out, (bf16_t*)(ws + WS_XN), DM, ss2};
        pg8::gemm_phase<pg8::EpiResid, pg8::StaticOrder, true, true>(lds, g, S, E);
    } SEAM(6);
    if (IN(7)) {
        {
            pg8::Gemm g{(const bf16_t*)(ws + WS_XN), (const bf16_t*)(ws + WS_WG), MT, DM, DM, DM, 0}; pg8::PanelOrder S{(int)blockIdx.x, G, MT / 256};
            pg8::EpiPle E{a.out, (const bf16_t*)(ws + WS_PR), DM, ss2, ssp, a.in[I_PPOST], nullptr};
            pg8::gemm_phase<pg8::EpiPle, pg8::PanelOrder, true, true>(lds, g, S, E);
            asm volatile("s_waitcnt vmcnt(0)" ::: "memory"); __syncthreads(); __builtin_amdgcn_fence(__ATOMIC_ACQUIRE, "agent"); asm volatile("s_waitcnt vmcnt(0)" ::: "memory"); __syncthreads();
            { const int lane = threadIdx.x & 63, wv = threadIdx.x >> 6; f32x4 gv[4];
#pragma unroll
              for (int j = 0; j < 4; ++j) gv[j] = *((const f32x4*)a.in[I_FINAL] + lane + 64 * j);
              for (int pm = blockIdx.x; pm < MT / 256; pm += G)
              for (int r = wv; r < 256; r += 8) { f32x4* xr = (f32x4*)(a.out + ((size_t)pm * 256 + r) * DM) + lane; f32x4 v[4]; float sq = 0.f;
#pragma unroll
                  for (int j = 0; j < 4; ++j) { v[j] = xr[64 * j]; sq += pg8::sq4(v[j]); }
                  const float rstd = rsqrtf(wave_sum(sq) * (1.f / DM) + MK_EPS);
#pragma unroll
                  for (int j = 0; j < 4; ++j) __builtin_nontemporal_store(v[j] * rstd * gv[j], xr + 64 * j); } }
        }
    } SEAM(7);
#undef IN
#undef SEAM
}

extern "C" void kernel_launch(void* const* d_in, const int* in_sizes, int n_in, void* d_out, int out_size, void* d_ws, size_t ws_size, hipStream_t stream) {
    static int grid = 0;
    if (grid == 0) {
        if (n_in != 23 || in_sizes[0] != MT * DM || out_size != MT * DM || ws_size < WS_END) { fprintf(stderr, "kernel_launch: unexpected shapes (n_in %d, in0 %d, out %d, ws %zu)\n", n_in, n_in > 0 ? in_sizes[0] : -1, out_size, ws_size); grid = -1; return; }
        int dev = 0, cus = 0, per_cu = 0;
        if (hipGetDevice(&dev) != hipSuccess || hipDeviceGetAttribute(&cus, hipDeviceAttributeMultiprocessorCount, dev) != hipSuccess) { grid = -1; return; }
        if (hipFuncSetAttribute((const void*)mega_fwd, hipFuncAttributeMaxDynamicSharedMemorySize, LDS_BYTES) != hipSuccess) { fprintf(stderr, "kernel_launch: hipFuncSetAttribute failed\n"); grid = -1; return; }
        if (hipOccupancyMaxActiveBlocksPerMultiprocessor(&per_cu, (const void*)mega_fwd, 512, LDS_BYTES) != hipSuccess || per_cu < 1) { fprintf(stderr, "kernel_launch: occupancy query says %d\n", per_cu); per_cu = 1; }
        (void)hipGetLastError();
        grid = cus;
    }
    if (grid < 0) return;
    Args a{};
    for (int i = 0; i < 23; ++i) a.in[i] = (const float*)d_in[i];
    a.out = (float*)d_out; a.ws = (unsigned char*)d_ws;
#if MK_N_LAUNCHES == 1
    a.ph_lo = 0; a.ph_hi = NPH;
    void* params[] = {&a};
    hipError_t e = hipLaunchCooperativeKernel((const void*)mega_fwd, dim3(grid), dim3(512), params, LDS_BYTES, stream);
    if (e != hipSuccess) fprintf(stderr, "kernel_launch: cooperative launch failed: %s (grid %d)\n", hipGetErrorString(e), grid);
#else
    for (int p = 0; p < NPH; ++p) { a.ph_lo = p; a.ph_hi = p + 1; hipLaunchKernelGGL(mega_fwd, dim3(grid), dim3(512), LDS_BYTES, stream, a); }
#endif
}
```

```cpp
#include <hip/hip_runtime.h>
#include <hip/hip_bf16.h>
#include <hip/hip_cooperative_groups.h>
#include <cstdio>
#include <cstdint>
#include <cmath>
namespace cg = cooperative_groups;
#ifndef MK_REP_SMALL
#define MK_REP_SMALL 1
#endif
#ifndef MK_REP_P2
#define MK_REP_P2 1
#endif
#ifndef MK_REP_SYNC
#define MK_REP_SYNC 1
#endif
#ifndef MK_REP_UP
#define MK_REP_UP 1
#endif
#ifndef MK_REP_ML
#define MK_REP_ML 1
#endif
#ifndef MK_REP_ATT
#define MK_REP_ATT 1
#endif
#ifndef MK_N_LAUNCHES
#define MK_N_LAUNCHES 1
#endif
namespace pg8 {
#define PG8_LAS __attribute__((address_space(3)))
typedef unsigned short bf16_t;
typedef short bf16x8 __attribute__((ext_vector_type(8)));
typedef float f32x4 __attribute__((ext_vector_type(4)));
typedef unsigned u32x4 __attribute__((ext_vector_type(4)));
constexpr int BM = 256, BK = 64, HALF = 128, HTB = HALF * BK * 2  , STAGE_BYTES = 8 * HTB, NXCD = 8, WGM = 8;

__host__ __device__ __forceinline__ int lds_byte(int r, int c) { const int st = (r >> 4) * 2 + (c >> 5), rr = r & 15, cc = c & 31, ob = rr * 64 + cc * 2; return st * 1024 + (ob ^ (((ob >> 9) & 1) << 5)); }
__host__ __device__ __forceinline__ void stage_rc(int b, int& R, int& C) { const int st = b / 1024, sb = b % 1024, swz = sb ^ (((sb >> 9) & 1) << 5); R = (st >> 1) * 16 + swz / 64; C = (st & 1) * 32 + (swz % 64) / 2; }
__host__ __device__ __forceinline__ int perm32(int rho) { const int n = rho >> 4, i = rho & 15; return 8 * (i >> 2) + 4 * n + (i & 3); }

struct Unit { int pm, pn; };
struct Gemm { const bf16_t* A; const bf16_t* Bt; int M, N, K, lda, amode; };
__host__ __device__ __forceinline__ size_t arow0(const Gemm& g, int pm) { return g.amode ? (size_t)(pm / 33) * 8192 + (size_t)(pm % 33) * 252 : (size_t)pm * 256; }

struct StaticOrder {
    int nM, nN, nwg, G, c;
    __host__ __device__ void init(int M, int N, int G_, int c_) { nM = M / BM; nN = N / BM; nwg = nM * nN; G = G_; c = c_; }
    __host__ __device__ bool next(int i, Unit& u) const {
        const long L = (long)i * G + c; if (L >= nwg) return false;
        int wgid = (int)L; { const int q = nwg / NXCD, r = nwg % NXCD, xcd = wgid % NXCD, off = wgid / NXCD; wgid = (xcd < r ? xcd * (q + 1) : r * (q + 1) + (xcd - r) * q) + off; }
        const int nig = WGM * nN, gid = wgid / nig, fm = gid * WGM, gsz = (nM - fm) < WGM ? (nM - fm) : WGM;
        u.pm = fm + ((wgid % nig) % gsz); u.pn = (wgid % nig) / gsz; return true;
    }
    __device__ __forceinline__ void a_ready(const Unit&) const {}
    __device__ __forceinline__ void done(const Unit&) const {}
};

__device__ __forceinline__ unsigned cvt_pk_bf16(float lo, float hi) { unsigned r; asm volatile("v_cvt_pk_bf16_f32 %0, %1, %2" : "=v"(r) : "v"(lo), "v"(hi)); return r; }
typedef float f32x2 __attribute__((ext_vector_type(2)));
__device__ __forceinline__ f32x2 gelu_pk(f32x2 v) {
    const f32x2 av = __builtin_elementwise_abs(v), d = av * 0.2316418882f + 1.0f;
    f32x2 t; t.x = __builtin_amdgcn_rcpf(d.x); t.y = __builtin_amdgcn_rcpf(d.y);
    f32x2 q = t * 0.5307027145f + (-0.7265760135f); q = q * t + 0.7107068705f; q = q * t + (-0.142248368f); q = q * t + 0.127414796f; q = q * t;
    const f32x2 s = (v * v) * (-0.72134752044f);
    f32x2 e; e.x = __builtin_amdgcn_exp2f(s.x); e.y = __builtin_amdgcn_exp2f(s.y);
    const f32x2 m = v * (q * e), r = v - m;
    f32x2 o; o.x = v.x < 0.f ? m.x : r.x; o.y = v.y < 0.f ? m.y : r.y; return o;
}

template <int ACT  > struct EpiBf16 {
    static constexpr bool PERM = true, AFTER_DRAIN = false; static_assert(ACT == 0 || ACT == 1, "EpiBf16: ACT is 0 (none) or 1 (gelu_pk)");
    bf16_t* O; int ldc; const float* bias; int split_cols; size_t split_stride; float scale0;
    __device__ __forceinline__ void operator()(const f32x4 (&acc)[2][2][4][2], const Unit& u, int wr, int wc, int fr, int fq) const {
        const int row0 = u.pm * BM + wr * 64 + fr; int colt = u.pn * BM; bf16_t* base = O;
        float sc = 1.f; if (split_cols) { const int t = colt / split_cols; base += (size_t)t * split_stride; colt -= t * split_cols; if (t == 0) sc = scale0; }
        const int col0 = colt + wc * 32 + 8 * fq, bcol0 = u.pn * BM + wc * 32 + 8 * fq;
        f32x4 bv[2][2];
#pragma unroll
        for (int bj = 0; bj < 2; ++bj)
#pragma unroll
            for (int n = 0; n < 2; ++n) bv[bj][n] = bias ? *(const f32x4*)(bias + bcol0 + bj * HALF + 4 * n) : (f32x4){0.f, 0.f, 0.f, 0.f};
#pragma unroll
        for (int ai = 0; ai < 2; ++ai)
#pragma unroll
            for (int m = 0; m < 4; ++m) { bf16_t* rowp = base + (size_t)(row0 + ai * HALF + m * 16) * ldc + col0;
#pragma unroll
                for (int bj = 0; bj < 2; ++bj) { f32x4 v0 = acc[ai][bj][m][0] + bv[bj][0], v1 = acc[ai][bj][m][1] + bv[bj][1];
                    if (ACT == 1) { f32x2 a = gelu_pk((f32x2){v0[0], v0[1]}), b = gelu_pk((f32x2){v0[2], v0[3]}), c = gelu_pk((f32x2){v1[0], v1[1]}), d = gelu_pk((f32x2){v1[2], v1[3]});
                        v0 = (f32x4){a.x, a.y, b.x, b.y}; v1 = (f32x4){c.x, c.y, d.x, d.y}; }
                    v0 = v0 * sc; v1 = v1 * sc; u32x4 w; w.x = cvt_pk_bf16(v0[0], v0[1]); w.y = cvt_pk_bf16(v0[2], v0[3]); w.z = cvt_pk_bf16(v1[0], v1[1]); w.w = cvt_pk_bf16(v1[2], v1[3]);
                    *(u32x4*)(rowp + bj * HALF) = w; } }
    }
};
struct PanelOrder {
    int c, G, nM;
    __host__ __device__ bool next(int i, Unit& u) const { const int pm = c + (i >> 2) * G; if (pm >= nM) return false; u.pm = pm; u.pn = (i + (c >> 3)) & 3; return true; }
    __device__ __forceinline__ void a_ready(const Unit&) const {}
    __device__ __forceinline__ void done(const Unit&) const {}
};
#define MK_EPS 1e-6f
__device__ __forceinline__ float sq4(f32x4 v) { return (v[0] * v[0] + v[1] * v[1]) + (v[2] * v[2] + v[3] * v[3]); }
__device__ __forceinline__ float red_fq(float s) { s += __shfl_xor(s, 16); s += __shfl_xor(s, 32); return s; }
__device__ __forceinline__ u32x4 pack8(f32x4 v0, f32x4 v1) { u32x4 w; w.x = cvt_pk_bf16(v0[0], v0[1]); w.y = cvt_pk_bf16(v0[2], v0[3]); w.z = cvt_pk_bf16(v1[0], v1[1]); w.w = cvt_pk_bf16(v1[2], v1[3]); return w; }
__device__ __forceinline__ float bf_lo(unsigned w) { return __uint_as_float(w << 16); }
__device__ __forceinline__ float bf_hi(unsigned w) { return __uint_as_float(w & 0xffff0000u); }

struct EpiProj {
    static constexpr bool PERM = true, AFTER_DRAIN = false;
    bf16_t* O; int ldc; float* ssq; float* sskv;
    __device__ __forceinline__ void operator()(const f32x4 (&acc)[2][2][4][2], const Unit& u, int wr, int wc, int fr, int fq) const {
        const int row0 = u.pm * BM + wr * 64 + fr, col0 = u.pn * BM + wc * 32 + 8 * fq;
#pragma unroll
        for (int ai = 0; ai < 2; ++ai)
#pragma unroll
            for (int m = 0; m < 4; ++m) { const int row = row0 + ai * HALF + m * 16; bf16_t* rowp = O + (size_t)row * ldc + col0; float s0 = 0.f, s1 = 0.f;
#pragma unroll
                for (int bj = 0; bj < 2; ++bj) { const f32x4 v0 = acc[ai][bj][m][0], v1 = acc[ai][bj][m][1]; *(u32x4*)(rowp + bj * HALF) = pack8(v0, v1);
                    const float q = sq4(v0) + sq4(v1); if (bj == 0) s0 += q; else s1 += q; }
                if (u.pn == 8) { const float s = red_fq(s0 + s1); if (fq == 0) unsafeAtomicAdd(ssq + row, s); }
                else if (u.pn == 9) { const float s = red_fq(s0); if (fq == 0) unsafeAtomicAdd(sskv + row, s); } }
    }
};
struct EpiScale {
    static constexpr bool PERM = true, AFTER_DRAIN = false;
    bf16_t* O; int ldc; const float* ss_in; float inv_dim; float* ss_out;
    __device__ __forceinline__ void operator()(const f32x4 (&acc)[2][2][4][2], const Unit& u, int wr, int wc, int fr, int fq) const {
        const int row0 = u.pm * BM + wr * 64 + fr, col0 = u.pn * BM + wc * 32 + 8 * fq;
#pragma unroll
        for (int ai = 0; ai < 2; ++ai)
#pragma unroll
            for (int m = 0; m < 4; ++m) { const int row = row0 + ai * HALF + m * 16; bf16_t* rowp = O + (size_t)row * ldc + col0; float s = 0.f;
                const float sc = ss_in ? rsqrtf(ss_in[row] * inv_dim + MK_EPS) : 1.f;
#pragma unroll
                for (int bj = 0; bj < 2; ++bj) { const f32x4 v0 = acc[ai][bj][m][0] * sc, v1 = acc[ai][bj][m][1] * sc; *(u32x4*)(rowp + bj * HALF) = pack8(v0, v1); s += sq4(v0) + sq4(v1); }
                if (ss_out) { s = red_fq(s); if (fq == 0) unsafeAtomicAdd(ss_out + row, s); } }
    }
};
struct EpiResid {
    static constexpr bool PERM = true, AFTER_DRAIN = false;
    const float* base; float* out; bf16_t* ob; int ldc; float* ss_out;
    __device__ __forceinline__ void operator()(const f32x4 (&acc)[2][2][4][2], const Unit& u, int wr, int wc, int fr, int fq) const {
        const int row0 = u.pm * BM + wr * 64 + fr, col0 = u.pn * BM + wc * 32 + 8 * fq;
#pragma unroll
        for (int ai = 0; ai < 2; ++ai)
#pragma unroll
            for (int m = 0; m < 4; ++m) { const int row = row0 + ai * HALF + m * 16; const size_t off = (size_t)row * ldc + col0; float s = 0.f;
#pragma unroll
                for (int bj = 0; bj < 2; ++bj) { const f32x4 b0 = *(const f32x4*)(base + off + bj * HALF), b1 = *(const f32x4*)(base + off + bj * HALF + 4);
                    const f32x4 v0 = acc[ai][bj][m][0] + b0, v1 = acc[ai][bj][m][1] + b1;
                    *(f32x4*)(out + off + bj * HALF) = v0; *(f32x4*)(out + off + bj * HALF + 4) = v1; *(u32x4*)(ob + off + bj * HALF) = pack8(v0, v1); s += sq4(v0) + sq4(v1); }
                s = red_fq(s); if (fq == 0) unsafeAtomicAdd(ss_out + row, s);
                if (m & 1) asm volatile("" ::: "memory"); }
    }
};

struct EpiConvAct {
    static constexpr bool PERM = true, AFTER_DRAIN = false;
    bf16_t* act; const float* ss1; const float* cw; const float* cb;
    __device__ __forceinline__ void operator()(f32x4 (&acc)[2][2][4][2], const Unit& u, int wr, int wc, int fr, int fq) const {
        const int seq = u.pm / 33, p0 = 252 * (u.pm % 33) + 126 * wr + 8 * fr - 1;
        const size_t tokb = (size_t)seq * 8192; const int col = u.pn * 128 + wc * 32 + 8 * fq;
        { const float* sp = ss1 + tokb;
#pragma unroll
          for (int ai = 0; ai < 2; ++ai)
#pragma unroll
            for (int m = 0; m < 4; ++m) { const int pos = p0 + 4 * ai + m; const bool in = pos >= 0 && pos < 8192; const float sc = in ? rsqrtf(sp[in ? pos : 0] * (1.f / 1024.f) + MK_EPS) : 0.f;
#pragma unroll
                for (int bj = 0; bj < 2; ++bj)
#pragma unroll
                    for (int n = 0; n < 2; ++n)
#pragma unroll
                        for (int i = 0; i < 4; ++i) acc[ai][bj][m][n][i] = in ? acc[ai][bj][m][n][i] * sc : 0.f; } }
        asm volatile("" ::: "memory"); __builtin_amdgcn_sched_barrier(0);
#pragma unroll
        for (int n = 0; n < 2; ++n) {
            const int c4 = col + 4 * n;
            const f32x4 WG0 = *(const f32x4*)(cw + c4), WG1 = *(const f32x4*)(cw + 5632 + c4), WG2 = *(const f32x4*)(cw + 2 * 5632 + c4), BG = *(const f32x4*)(cb + c4),
                        WV0 = *(const f32x4*)(cw + 2816 + c4), WV1 = *(const f32x4*)(cw + 5632 + 2816 + c4), WV2 = *(const f32x4*)(cw + 2 * 5632 + 2816 + c4), BV = *(const f32x4*)(cb + 2816 + c4);
#pragma unroll
            for (int i = 0; i < 4; ++i) {
                const float wg0 = WG0[i], wg1 = WG1[i], wg2 = WG2[i], bg = BG[i], wv0 = WV0[i], wv1 = WV1[i], wv2 = WV2[i], bv = BV[i];
                float g[10], v[10];
#pragma unroll
                for (int k = 0; k < 8; ++k) { g[k + 1] = acc[k >> 2][0][k & 3][n][i]; v[k + 1] = acc[k >> 2][1][k & 3][n][i]; }
                g[0] = __int_as_float(__builtin_amdgcn_mov_dpp(__float_as_int(g[8]), 0x111, 0xf, 0xf, true)); v[0] = __int_as_float(__builtin_amdgcn_mov_dpp(__float_as_int(v[8]), 0x111, 0xf, 0xf, true));
                g[9] = __int_as_float(__builtin_amdgcn_mov_dpp(__float_as_int(g[1]), 0x101, 0xf, 0xf, true)); v[9] = __int_as_float(__builtin_amdgcn_mov_dpp(__float_as_int(v[1]), 0x101, 0xf, 0xf, true));
                float o[8];
#pragma unroll
                for (int k = 0; k < 8; ++k) { const float ug = wg0 * g[k] + wg1 * g[k + 1] + wg2 * g[k + 2] + bg, uv = wv0 * v[k] + wv1 * v[k + 1] + wv2 * v[k + 2] + bv;
                    o[k] = ug * __builtin_amdgcn_rcpf(1.f + __expf(-ug)) * uv; }
                asm volatile("" : "+v"(o[0]), "+v"(o[1]), "+v"(o[2]), "+v"(o[3]), "+v"(o[4]), "+v"(o[5]), "+v"(o[6]), "+v"(o[7]) :: "memory");
#pragma unroll
                for (int k = 0; k < 8; ++k) acc[k >> 2][0][k & 3][n][i] = o[k];
                __builtin_amdgcn_sched_barrier(0); } }
        { int p0l = p0, frl = fr; asm volatile("" : "+v"(p0l), "+v"(frl));
          bf16_t* rp = act + ((long)tokb + p0l) * 2816 + col;
#pragma unroll
          for (int k = 0; k < 8; ++k) { const int to = 8 * frl + k - 1, pos = p0l + k;
              if (to >= 0 && to < 126 && pos < 8192) *(u32x4*)(rp + k * 2816) = pack8(acc[k >> 2][0][k & 3][0], acc[k >> 2][0][k & 3][1]); } }
    }
};
struct EpiPle {
    static constexpr bool PERM = true, AFTER_DRAIN = false;
    float* h; const bf16_t* pr; int ldc; const float* ss2; const float* ssp; const float* gpost; float* ss3;
    __device__ __forceinline__ void operator()(const f32x4 (&acc)[2][2][4][2], const Unit& u, int wr, int wc, int fr, int fq) const {
        const int row0 = u.pm * BM + wr * 64 + fr, col0 = u.pn * BM + wc * 32 + 8 * fq;
        f32x4 g0[2], g1[2];
#pragma unroll
        for (int bj = 0; bj < 2; ++bj) { g0[bj] = *(const f32x4*)(gpost + col0 + bj * HALF); g1[bj] = *(const f32x4*)(gpost + col0 + bj * HALF + 4); }
#pragma unroll
        for (int ai = 0; ai < 2; ++ai)
#pragma unroll
            for (int m = 0; m < 4; ++m) { const int row = row0 + ai * HALF + m * 16; const size_t off = (size_t)row * ldc + col0; float s = 0.f;
                const float r2 = rsqrtf(ss2[row] * (1.f / 1024.f) + MK_EPS), rp = rsqrtf(ssp[row] * (1.f / 1024.f) + MK_EPS);
#pragma unroll
                for (int bj = 0; bj < 2; ++bj) { const f32x4 h0 = *(const f32x4*)(h + off + bj * HALF), h1 = *(const f32x4*)(h + off + bj * HALF + 4); const u32x4 pw = *(const u32x4*)(pr + off + bj * HALF);
                    const f32x4 p0 = (f32x4){bf_lo(pw.x), bf_hi(pw.x), bf_lo(pw.y), bf_hi(pw.y)} * rp * g0[bj], p1 = (f32x4){bf_lo(pw.z), bf_hi(pw.z), bf_lo(pw.w), bf_hi(pw.w)} * rp * g1[bj];
                    f32x4 a0 = acc[ai][bj][m][0] * r2, a1 = acc[ai][bj][m][1] * r2, v0, v1;
#pragma unroll
                    for (int i = 0; i < 4; ++i) { v0[i] = h0[i] + p0[i] / (1.f + __expf(-a0[i])); v1[i] = h1[i] + p1[i] / (1.f + __expf(-a1[i])); }
                    *(f32x4*)(h + off + bj * HALF) = v0; *(f32x4*)(h + off + bj * HALF + 4) = v1; s += sq4(v0) + sq4(v1); }
                if (ss3) { s = red_fq(s); if (fq == 0) unsafeAtomicAdd(ss3 + row, s); }
                if (m & 1) asm volatile("" ::: "memory"); }
    }
};
template <class Epi, class Sched, bool ALIGN_EPI = false, bool SP2 = false>
__device__ __forceinline__ void gemm_phase(PG8_LAS unsigned char* lds, const Gemm g, const Sched& S, const Epi& E) {
    const int tid = threadIdx.x, wid = __builtin_amdgcn_readfirstlane(tid >> 6), lane = tid & 63, wr = wid >> 2, wc = wid & 3, fr = lane & 15, fq = lane >> 4;
    const int K = g.K, nt = K / BK;
    unsigned voffA[2], voffB[2];
#pragma unroll
    for (int i = 0; i < 2; ++i) { int R, C; stage_rc(tid * 16 + i * 8192, R, C); const int Rb = Epi::PERM ? ((R & ~31) + perm32(R & 31)) : R;
        { const int Ra = g.amode ? ((R >> 6) * 126 + (R & 15) * 8 + ((R >> 4) & 3)) : R; voffA[i] = (unsigned)(Ra * g.lda + C) * 2u; } voffB[i] = (unsigned)(Rb * K + C) * 2u; }
    const size_t kstep = (size_t)(BK * 2);
    const size_t hstep = (size_t)HALF * K * 2;
    const size_t tstep = 2 * hstep; const size_t hstepA = (size_t)(g.amode ? 4 : HALF) * g.lda * 2, rowB = (size_t)g.lda * 2;
    const unsigned ldsw = (unsigned)wid * 1024u;
    const int aoff = lds_byte(wr * 64 + fr, fq * 8), boff = lds_byte(wc * 32 + fr, fq * 8);
#define PG8_SA(b, h) (((b) * 2 + (h)) * HTB)
#define PG8_SB(b, h) ((4 + (b) * 2 + (h)) * HTB)
#define PG8_STAGE(bufoff, gbase, voff) do { _Pragma("unroll") for (int _i = 0; _i < 2; ++_i) \
        __builtin_amdgcn_global_load_lds((const unsigned*)((const char*)(gbase) + (voff)[_i]), (PG8_LAS unsigned*)(lds + (bufoff) + ldsw + _i * 8192), 16, 0, 0); } while (0)
#define PG8_LDA(dst, b, h) do { _Pragma("unroll") for (int m = 0; m < 4; ++m) _Pragma("unroll") for (int k = 0; k < 2; ++k) dst[m][k] = *(const PG8_LAS bf16x8*)(lds + PG8_SA(b, h) + aoff + m * 2048 + k * 1024); } while (0)
#define PG8_LDB(dst, b, h) do { _Pragma("unroll") for (int n = 0; n < 2; ++n) _Pragma("unroll") for (int k = 0; k < 2; ++k) dst[n][k] = *(const PG8_LAS bf16x8*)(lds + PG8_SB(b, h) + boff + n * 2048 + k * 1024); } while (0)
#define PG8_MMA(ai, bj, At, Bt) do { __builtin_amdgcn_s_setprio(1); _Pragma("unroll") for (int m = 0; m < 4; ++m) _Pragma("unroll") for (int n = 0; n < 2; ++n) _Pragma("unroll") for (int k = 0; k < 2; ++k) \
        acc[ai][bj][m][n] = __builtin_amdgcn_mfma_f32_16x16x32_bf16(Bt[n][k], At[m][k], acc[ai][bj][m][n], 0, 0, 0); __builtin_amdgcn_s_setprio(0); } while (0)
#define PG8_WAIT_V(n) asm volatile("s_waitcnt vmcnt(" #n ")" ::: "memory")
#define PG8_WAIT_L(n) asm volatile("s_waitcnt lgkmcnt(" #n ")" ::: "memory")
#define PG8_BAR __builtin_amdgcn_s_barrier()
#define PG8_SCHED __builtin_amdgcn_sched_barrier(0)
    Unit cur, nxt; int ui = 0;
    if (!S.next(0, cur)) return;
    f32x4 acc[2][2][4][2];
#pragma unroll
    for (int a = 0; a < 2; ++a)
#pragma unroll
        for (int b = 0; b < 2; ++b)
#pragma unroll
            for (int m = 0; m < 4; ++m)
#pragma unroll
                for (int n = 0; n < 2; ++n) acc[a][b][m][n] = (f32x4){0.f, 0.f, 0.f, 0.f};
    bf16x8 At[4][2], B0[2][2], B1[2][2];
    const char* cA = (const char*)g.A + arow0(g, cur.pm) * rowB; const char* cB = (const char*)g.Bt + (size_t)cur.pn * tstep;
    S.a_ready(cur);
    if constexpr (SP2) {
        PG8_STAGE(PG8_SB(0, 0), cB, voffB); PG8_STAGE(PG8_SB(0, 1), cB + hstep, voffB); PG8_STAGE(PG8_SA(0, 0), cA, voffA); PG8_STAGE(PG8_SA(0, 1), cA + hstepA, voffA);
        if (wr == 1) PG8_BAR;
        PG8_WAIT_V(2); PG8_BAR;
        PG8_STAGE(PG8_SB(1, 0), cB + kstep, voffB); PG8_STAGE(PG8_SA(1, 0), cA + kstep, voffA); PG8_STAGE(PG8_SB(1, 1), cB + hstep + kstep, voffB);
        PG8_WAIT_V(6); PG8_BAR;
    } else {
        PG8_STAGE(PG8_SB(0, 0), cB, voffB); PG8_STAGE(PG8_SA(0, 0), cA, voffA); PG8_STAGE(PG8_SB(0, 1), cB + hstep, voffB); PG8_STAGE(PG8_SA(0, 1), cA + hstepA, voffA);
        if (wr == 1) PG8_BAR;
        PG8_WAIT_V(4); PG8_BAR;
        PG8_STAGE(PG8_SB(1, 0), cB + kstep, voffB); PG8_STAGE(PG8_SA(1, 0), cA + kstep, voffA); PG8_STAGE(PG8_SB(1, 1), cB + hstep + kstep, voffB);
        PG8_WAIT_V(6); PG8_BAR;
    }
    for (;;) {
        const bool has_next = S.next(ui + 1, nxt);
        const char* nA = has_next ? (const char*)g.A + arow0(g, nxt.pm) * rowB : cA; const char* nB = has_next ? (const char*)g.Bt + (size_t)nxt.pn * tstep : cB;
        for (int t = 0; t < nt; t += 2) {
            const bool last = (t == nt - 2);
            const char* a1 = cA + (size_t)(t + 1) * kstep;
            const char* a2 = last ? nA : cA + (size_t)(t + 2) * kstep; const char* b2 = last ? nB : cB + (size_t)(t + 2) * kstep;
            const char* a3 = a2 + kstep; const char* b3 = b2 + kstep;
            if (last && has_next) S.a_ready(nxt);
            if constexpr (SP2) {
            PG8_LDB(B0, 0, 0); PG8_LDB(B1, 0, 1); PG8_SCHED; PG8_LDA(At, 0, 0); PG8_STAGE(PG8_SA(1, 1), a1 + hstepA, voffA);
            PG8_WAIT_V(8); PG8_WAIT_L(0); PG8_BAR; PG8_MMA(0, 0, At, B0); PG8_MMA(0, 1, At, B1); PG8_BAR; PG8_SCHED;
            PG8_LDA(At, 0, 1); PG8_STAGE(PG8_SB(0, 0), b2, voffB); PG8_STAGE(PG8_SB(0, 1), b2 + hstep, voffB); PG8_STAGE(PG8_SA(0, 0), a2, voffA);
            PG8_WAIT_V(8); PG8_WAIT_L(0); PG8_BAR; PG8_MMA(1, 0, At, B0); PG8_MMA(1, 1, At, B1); PG8_BAR; PG8_SCHED;
            PG8_LDB(B0, 1, 0); PG8_LDB(B1, 1, 1); PG8_SCHED; PG8_LDA(At, 1, 0); PG8_STAGE(PG8_SA(0, 1), a2 + hstepA, voffA);
            PG8_WAIT_V(8); PG8_WAIT_L(0); PG8_BAR; PG8_MMA(0, 0, At, B0); PG8_MMA(0, 1, At, B1); PG8_BAR; PG8_SCHED;
            PG8_LDA(At, 1, 1); PG8_STAGE(PG8_SB(1, 0), b3, voffB); PG8_STAGE(PG8_SB(1, 1), b3 + hstep, voffB); PG8_STAGE(PG8_SA(1, 0), a3, voffA);
            PG8_WAIT_V(8); PG8_WAIT_L(0); PG8_BAR; PG8_MMA(1, 0, At, B0); PG8_MMA(1, 1, At, B1); PG8_BAR; PG8_SCHED;
            } else {
            PG8_LDB(B0, 0, 0); PG8_SCHED; PG8_LDA(At, 0, 0); PG8_STAGE(PG8_SA(1, 1), a1 + hstepA, voffA);
            PG8_WAIT_L(8); PG8_BAR; PG8_WAIT_L(0); PG8_MMA(0, 0, At, B0); PG8_BAR; PG8_SCHED;
            PG8_LDB(B1, 0, 1); PG8_STAGE(PG8_SB(0, 0), b2, voffB);
            PG8_BAR; PG8_WAIT_L(0); PG8_MMA(0, 1, At, B1); PG8_BAR;
            PG8_LDA(At, 0, 1); PG8_STAGE(PG8_SA(0, 0), a2, voffA);
            PG8_BAR; PG8_WAIT_L(0); PG8_MMA(1, 0, At, B0); PG8_BAR; PG8_SCHED;
            PG8_STAGE(PG8_SB(0, 1), b2 + hstep, voffB);
            PG8_WAIT_V(6); PG8_BAR; PG8_MMA(1, 1, At, B1); PG8_BAR;
            PG8_LDB(B0, 1, 0); PG8_SCHED; PG8_LDA(At, 1, 0); PG8_STAGE(PG8_SA(0, 1), a2 + hstepA, voffA);
            PG8_WAIT_L(8); PG8_BAR; PG8_WAIT_L(0); PG8_MMA(0, 0, At, B0); PG8_BAR; PG8_SCHED;
            PG8_LDB(B1, 1, 1); PG8_STAGE(PG8_SB(1, 0), b3, voffB);
            PG8_BAR; PG8_WAIT_L(0); PG8_MMA(0, 1, At, B1); PG8_BAR;
            PG8_LDA(At, 1, 1); PG8_STAGE(PG8_SA(1, 0), a3, voffA);
            PG8_BAR; PG8_WAIT_L(0); PG8_MMA(1, 0, At, B0); PG8_BAR; PG8_SCHED;
            PG8_STAGE(PG8_SB(1, 1), b3 + hstep, voffB);
            PG8_WAIT_V(6); PG8_BAR; PG8_MMA(1, 1, At, B1); PG8_BAR;
            }
        }
        if constexpr (ALIGN_EPI) { if (wr == 0) PG8_BAR; }
        if constexpr (!Epi::AFTER_DRAIN) { E(acc, cur, wr, wc, fr, fq); S.done(cur); }
        if (!has_next) break;
#pragma unroll
        for (int a = 0; a < 2; ++a)
#pragma unroll
            for (int b = 0; b < 2; ++b)
#pragma unroll
                for (int m = 0; m < 4; ++m)
#pragma unroll
                    for (int n = 0; n < 2; ++n) acc[a][b][m][n] = (f32x4){0.f, 0.f, 0.f, 0.f};
        cur = nxt; cA = nA; cB = nB; ++ui;
        if constexpr (ALIGN_EPI) { if (wr == 1) PG8_BAR; }
    }
    PG8_WAIT_V(0);
    if constexpr (!ALIGN_EPI) { if (wr == 0) PG8_BAR; }
    PG8_BAR;
    if constexpr (Epi::AFTER_DRAIN) { E.fused(acc, cur, wr, wc, fr, fq, lds, wid, lane); S.done(cur); }
#undef PG8_SA
#undef PG8_SB
#undef PG8_STAGE
#undef PG8_LDA
#undef PG8_LDB
#undef PG8_MMA
#undef PG8_WAIT_V
#undef PG8_WAIT_L
#undef PG8_BAR
#undef PG8_SCHED
}
}
namespace att {
using bf16 = __hip_bfloat16;
using bf16x8 = __attribute__((ext_vector_type(8))) short;
using s16x4  = __attribute__((ext_vector_type(4))) short;
using f32x16 = __attribute__((ext_vector_type(16))) float;
using f32x4  = __attribute__((ext_vector_type(4))) float;
using u32x4  = __attribute__((ext_vector_type(4))) unsigned;
constexpr int NW = 8, QBLK = 32, KVBLK = 64;
constexpr float SCALE = 0.07216878364870322f;
constexpr float THR = 8.f;
#ifndef ATT_SDEPTH
#define ATT_SDEPTH 1
#endif
constexpr int SDEPTH = ATT_SDEPTH;
#ifndef ATT_QLDS
#define ATT_QLDS 8
#endif
constexpr int QLDS = ATT_QLDS, QREG = 12 - QLDS;
constexpr int SHM_V = KVBLK * 128 * 2, SHM_K = KVBLK * 128 * 2, SHM_KR = KVBLK * 64 * 2;
constexpr int OFF_V = 0, OFF_K = 2 * SHM_V, OFF_KR = OFF_K + 2 * SHM_K, OFF_SCR = OFF_KR + 2 * SHM_KR, OFF_QL = OFF_SCR + NW * 64 * 4, SHM_ATTN = OFF_QL + NW * QLDS * 1024;
constexpr int LDQ = 768, LDKV = 1024, LDKR = 64, LDO = 1024;
#define KSWZ(row, colB) ((row) * 256 + ((colB) ^ (((row) & 7) << 4)))
#define KRSWZ(row, colB) ((row) * 128 + ((colB) ^ ((((row) >> 1) & 7) << 4)))
#define SBAR() __builtin_amdgcn_sched_barrier(0)
__device__ __forceinline__ int crow(int r, int hi) { return (r & 3) + 8 * (r >> 2) + 4 * hi; }
__device__ __forceinline__ unsigned cvtpk(float lo, float hi) { unsigned r; asm volatile("v_cvt_pk_bf16_f32 %0, %1, %2" : "=v"(r) : "v"(lo), "v"(hi)); return r; }
__device__ __forceinline__ bf16x8 ld8(const bf16* p) { return *reinterpret_cast<const bf16x8*>(p); }
__device__ __forceinline__ float bfv(short s) { return __uint_as_float(((unsigned)(unsigned short)s) << 16); }

__device__ __forceinline__ void partialSM(f32x16& p0, f32x16& p1, float& m_reg, float& mn, float& alpha) {
  constexpr float C = SCALE * 1.4426950408889634f;
  float pmax = p0[0]; for (int r = 1; r < 16; ++r) pmax = fmaxf(pmax, p0[r]); for (int r = 0; r < 16; ++r) pmax = fmaxf(pmax, p1[r]);
  { auto rr = __builtin_amdgcn_permlane32_swap(__float_as_uint(pmax), __float_as_uint(pmax), false, false);
    pmax = fmaxf(__uint_as_float(rr[0]), __uint_as_float(rr[1])); }
  if (__builtin_expect(__all(pmax - m_reg <= THR / SCALE), 1)) { mn = m_reg; alpha = 1.f; }
  else { mn = fmaxf(m_reg, pmax); alpha = __builtin_amdgcn_exp2f((m_reg - mn) * C); m_reg = mn; }
  float mnC = -mn * C;
  for (int r = 0; r < 16; ++r) p0[r] = fmaf(p0[r], C, mnC); for (int r = 0; r < 16; ++r) p1[r] = fmaf(p1[r], C, mnC);
  for (int r = 0; r < 16; ++r) p0[r] = __builtin_amdgcn_exp2f(p0[r]);
}
__device__ __forceinline__ void finishSM(f32x16& p0, f32x16& p1, float alpha, float& l_reg, bf16x8& pa0, bf16x8& pa1, bf16x8& pa2, bf16x8& pa3) {
  for (int r = 0; r < 16; ++r) p1[r] = __builtin_amdgcn_exp2f(p1[r]);
  float ps = 0; for (int r = 0; r < 16; ++r) ps += p0[r]; for (int r = 0; r < 16; ++r) ps += p1[r];
  { auto rr = __builtin_amdgcn_permlane32_swap(__float_as_uint(ps), __float_as_uint(ps), false, false);
    ps = __uint_as_float(rr[0]) + __uint_as_float(rr[1]); }
  l_reg = l_reg * alpha + ps;
#define PK4(P, BASE, OUT) do { unsigned a0 = cvtpk(P[BASE + 0], P[BASE + 1]), a1 = cvtpk(P[BASE + 2], P[BASE + 3]);   \
    unsigned b0 = cvtpk(P[BASE + 4], P[BASE + 5]), b1 = cvtpk(P[BASE + 6], P[BASE + 7]);                              \
    auto r0 = __builtin_amdgcn_permlane32_swap(a0, b0, false, false); auto r1 = __builtin_amdgcn_permlane32_swap(a1, b1, false, false); \
    u32x4 w = {r0[0], r1[0], r0[1], r1[1]}; OUT = *reinterpret_cast<bf16x8*>(&w); } while (0)
  PK4(p0, 0, pa0); PK4(p0, 8, pa1); PK4(p1, 0, pa2); PK4(p1, 8, pa3);
#undef PK4
}
__device__ __forceinline__ void qkt(f32x16& p0, f32x16& p1, const char* Ks, const char* Krs, const bf16x8* qr, const char* ql, int r32, int hi) {
#define QF(f) ((f) < QREG ? qr[(f) < QREG ? (f) : 0] : *reinterpret_cast<const bf16x8*>(ql + ((f) - QREG) * 1024))
  p0 = f32x16{}; p1 = f32x16{};
#pragma unroll
  for (int d0 = 0; d0 < 8; ++d0) { int cb = (d0 * 16 + hi * 8) * 2;
    bf16x8 b0 = *reinterpret_cast<const bf16x8*>(Ks + KSWZ(r32, cb));
    bf16x8 b1 = *reinterpret_cast<const bf16x8*>(Ks + KSWZ(32 + r32, cb));
    const bf16x8 qq = QF(d0);
    p0 = __builtin_amdgcn_mfma_f32_32x32x16_bf16(b0, qq, p0, 0, 0, 0);
    p1 = __builtin_amdgcn_mfma_f32_32x32x16_bf16(b1, qq, p1, 0, 0, 0); }
#pragma unroll
  for (int d0 = 0; d0 < 4; ++d0) { int cb = (d0 * 16 + hi * 8) * 2;
    bf16x8 b0 = *reinterpret_cast<const bf16x8*>(Krs + KRSWZ(r32, cb));
    bf16x8 b1 = *reinterpret_cast<const bf16x8*>(Krs + KRSWZ(32 + r32, cb));
    const bf16x8 qq = QF(8 + d0);
    p0 = __builtin_amdgcn_mfma_f32_32x32x16_bf16(b0, qq, p0, 0, 0, 0);
    p1 = __builtin_amdgcn_mfma_f32_32x32x16_bf16(b1, qq, p1, 0, 0, 0); }
#undef QF
}
__device__ __forceinline__ int v_st(int k, int c) { const int kk = (k & ~0xC) | ((k & 4) << 1) | ((k & 8) >> 1); return ((kk >> 3) * 4 + (c >> 5)) * 512 + ((kk & 7) * 32 + (c & 31)) * 2; }
__device__ __forceinline__ int v_rd_base(int lane) { return ((lane & 3) << 3) | (((lane >> 2) & 3) << 6) | (((lane >> 4) & 1) << 5) | (((lane >> 5) & 1) << 8); }
constexpr int v_rd_off(int d0, int ks, int half) { return d0 * 512 + ks * 4096 + half * 2048; }
template <int OFF> __device__ __forceinline__ s16x4 tr_read(int vb) {
  s16x4 r; asm volatile("ds_read_b64_tr_b16 %0, %1 offset:%2" : "=&v"(r) : "v"(vb), "i"(OFF) : "memory"); return r;
}
template <int D0> __device__ __forceinline__ void pv_one(f32x16& od, int vb, bf16x8 pa0, bf16x8 pa1, bf16x8 pa2, bf16x8 pa3) {
  const s16x4 l0 = tr_read<v_rd_off(D0, 0, 0)>(vb), h0 = tr_read<v_rd_off(D0, 0, 1)>(vb), l1 = tr_read<v_rd_off(D0, 1, 0)>(vb), h1 = tr_read<v_rd_off(D0, 1, 1)>(vb);
  const s16x4 l2 = tr_read<v_rd_off(D0, 2, 0)>(vb), h2 = tr_read<v_rd_off(D0, 2, 1)>(vb), l3 = tr_read<v_rd_off(D0, 3, 0)>(vb), h3 = tr_read<v_rd_off(D0, 3, 1)>(vb);
  asm volatile("s_waitcnt lgkmcnt(0)" ::: "memory"); SBAR();
#define PK(L, H) (bf16x8){L[0], L[1], L[2], L[3], H[0], H[1], H[2], H[3]}
  od = __builtin_amdgcn_mfma_f32_32x32x16_bf16(pa0, PK(l0, h0), od, 0, 0, 0);
  od = __builtin_amdgcn_mfma_f32_32x32x16_bf16(pa1, PK(l1, h1), od, 0, 0, 0);
  od = __builtin_amdgcn_mfma_f32_32x32x16_bf16(pa2, PK(l2, h2), od, 0, 0, 0);
  od = __builtin_amdgcn_mfma_f32_32x32x16_bf16(pa3, PK(l3, h3), od, 0, 0, 0);
#undef PK
}
__device__ __forceinline__ void pv_d0(f32x16* o, int vb, bf16x8 pa0, bf16x8 pa1, bf16x8 pa2, bf16x8 pa3) {
  pv_one<0>(o[0], vb, pa0, pa1, pa2, pa3); pv_one<1>(o[1], vb, pa0, pa1, pa2, pa3); pv_one<2>(o[2], vb, pa0, pa1, pa2, pa3); pv_one<3>(o[3], vb, pa0, pa1, pa2, pa3);
}
__device__ __forceinline__ void attn_unit(const bf16* __restrict__ Qb, const bf16* __restrict__ Kn, const bf16* __restrict__ Vh, const bf16* __restrict__ Kr,
                                          unsigned short* __restrict__ Ob, const float* __restrict__ costab, const float* __restrict__ sintab, int qpos0, int seq, char* lds) {
  const int tid = threadIdx.x, wid = tid >> 6, lane = tid & 63, r32 = lane & 31, hi = lane >> 5;
  char* V_lds = lds + OFF_V; char* K_lds = lds + OFF_K; char* KR_lds = lds + OFF_KR;
  float* ws = (float*)(lds + OFF_SCR) + wid * 64; float* li_l = ws; float* al_l = ws + 32;
  float m_reg = -1e30f, l_reg = 0; f32x16 o[4] = {}; bf16x8 qr[QREG > 0 ? QREG : 1]; char* ql = lds + OFF_QL + wid * (QLDS * 1024) + lane * 16;
#define QSET(f, v) do { if ((f) < QREG) qr[(f) < QREG ? (f) : 0] = (v); else *reinterpret_cast<bf16x8*>(ql + ((f) - QREG) * 1024) = (v); } while (0)
  const bf16* Qw = Qb + (long)(wid * QBLK + r32) * LDQ + hi * 8;
#pragma unroll
  for (int d0 = 0; d0 < 8; ++d0) QSET(d0, ld8(Qw + d0 * 16));
  { const int qp = qpos0 + wid * QBLK + r32;
#pragma unroll
    for (int d0 = 0; d0 < 2; ++d0) {
      const bf16x8 x1 = ld8(Qw + 128 + d0 * 16), x2 = ld8(Qw + 128 + 32 + d0 * 16);
      const float* cp = costab + (long)qp * 32 + d0 * 16 + hi * 8; const float* sp = sintab + (long)qp * 32 + d0 * 16 + hi * 8;
      const f32x4 c0 = *(const f32x4*)cp, c1 = *(const f32x4*)(cp + 4), s0 = *(const f32x4*)sp, s1 = *(const f32x4*)(sp + 4);
      float o1[8], o2[8];
#pragma unroll
      for (int j = 0; j < 8; ++j) { const float a = bfv(x1[j]), b = bfv(x2[j]), c = j < 4 ? c0[j] : c1[j - 4], s = j < 4 ? s0[j] : s1[j - 4]; o1[j] = a * c - b * s; o2[j] = b * c + a * s; }
      u32x4 w1 = {cvtpk(o1[0], o1[1]), cvtpk(o1[2], o1[3]), cvtpk(o1[4], o1[5]), cvtpk(o1[6], o1[7])};
      u32x4 w2 = {cvtpk(o2[0], o2[1]), cvtpk(o2[2], o2[3]), cvtpk(o2[4], o2[5]), cvtpk(o2[6], o2[7])};
      QSET(8 + d0, *reinterpret_cast<bf16x8*>(&w1)); QSET(10 + d0, *reinterpret_cast<bf16x8*>(&w2));
    } }
  const int sr = tid >> 4, sc = (tid & 15) * 8, vst0 = v_st(sr, sc), vst1 = v_st(32 + sr, sc);
  const int krow = tid >> 3, kcol = (tid & 7) * 8;
  const int vb0 = (int)(uintptr_t)V_lds + v_rd_base(lane);
  struct { bf16x8 vs0, vs1, ks0, ks1, kr0; } sr_[SDEPTH];
  const unsigned voff_kv = (unsigned)(sr * LDKV + sc) * 2u, voff_kr = (unsigned)(krow * LDKR + kcol) * 2u;
#define SLOAD(i, k0) do { const char* kt_ = (const char*)Kn + (size_t)(k0) * (LDKV * 2); const char* kt2_ = kt_ + 32 * LDKV * 2; const char* rt_ = (const char*)Kr + (size_t)(k0) * (LDKR * 2); \
    sr_[i].vs0 = *reinterpret_cast<const bf16x8*>(kt_ + voff_kv + 256); sr_[i].vs1 = *reinterpret_cast<const bf16x8*>(kt2_ + voff_kv + 256); \
    sr_[i].ks0 = *reinterpret_cast<const bf16x8*>(kt_ + voff_kv); sr_[i].ks1 = *reinterpret_cast<const bf16x8*>(kt2_ + voff_kv); \
    sr_[i].kr0 = *reinterpret_cast<const bf16x8*>(rt_ + voff_kr); } while (0)
#define SWRITE(b, i) do { *(bf16x8*)(V_lds + (b) * SHM_V + vst0) = sr_[i].vs0;          \
    *(bf16x8*)(V_lds + (b) * SHM_V + vst1) = sr_[i].vs1; int kc = sc * 2;               \
    *(bf16x8*)(K_lds + (b) * SHM_K + KSWZ(sr, kc)) = sr_[i].ks0;                       \
    *(bf16x8*)(K_lds + (b) * SHM_K + KSWZ(32 + sr, kc)) = sr_[i].ks1;                  \
    *(bf16x8*)(KR_lds + (b) * SHM_KR + KRSWZ(krow, kcol * 2)) = sr_[i].kr0; } while (0)
#define SWAIT() do { if constexpr (SDEPTH == 2) asm volatile("s_waitcnt vmcnt(5)" ::: "memory"); else asm volatile("s_waitcnt vmcnt(0)" ::: "memory"); } while (0)
#define RESC(a) do { if (__any((a) < 1.f)) { if (hi == 0) al_l[r32] = (a); asm volatile("s_waitcnt lgkmcnt(0)" ::: "memory"); \
    for (int d = 0; d < 4; ++d) for (int r = 0; r < 16; ++r) o[d][r] *= al_l[crow(r, hi)]; } } while (0)
  f32x16 pA0, pA1, pB0, pB1; float mnA, mnB, alA, alB; bf16x8 pa0, pa1, pa2, pa3; const int NT = seq / KVBLK;
  constexpr int SE = 0, SO = SDEPTH - 1;
  SLOAD(SE, 0); asm volatile("s_waitcnt vmcnt(0)" ::: "memory"); SWRITE(0, SE); __syncthreads();
  qkt(pA0, pA1, K_lds, KR_lds, qr, ql, r32, hi); partialSM(pA0, pA1, m_reg, mnA, alA);
  SLOAD(SO, KVBLK); if constexpr (SDEPTH == 2) { if (2 < NT) SLOAD(SE, 2 * KVBLK); }
  SWAIT(); SWRITE(1, SO); __syncthreads();
  for (int j = 1; j + 1 < NT; j += 2) {
    SBAR(); qkt(pB0, pB1, K_lds + SHM_K, KR_lds + SHM_KR, qr, ql, r32, hi);
    finishSM(pA0, pA1, alA, l_reg, pa0, pa1, pa2, pa3); SBAR();
    SLOAD(SO, (j + SDEPTH) * KVBLK); SBAR();
    pv_d0(o, vb0, pa0, pa1, pa2, pa3); partialSM(pB0, pB1, m_reg, mnB, alB);
    __syncthreads(); SWAIT(); SWRITE(0, SE);
    RESC(alB); __syncthreads();
    SBAR(); qkt(pA0, pA1, K_lds, KR_lds, qr, ql, r32, hi);
    finishSM(pB0, pB1, alB, l_reg, pa0, pa1, pa2, pa3); SBAR();
    if (SDEPTH == 1 || j + 3 < NT) SLOAD(SE, (j + 1 + SDEPTH) * KVBLK); SBAR();
    pv_d0(o, vb0 + (int)SHM_V, pa0, pa1, pa2, pa3); partialSM(pA0, pA1, m_reg, mnA, alA);
    __syncthreads(); SWAIT(); SWRITE(1, SO);
    RESC(alA); __syncthreads();
  }
  SBAR(); qkt(pB0, pB1, K_lds + SHM_K, KR_lds + SHM_KR, qr, ql, r32, hi);
  finishSM(pA0, pA1, alA, l_reg, pa0, pa1, pa2, pa3); SBAR();
  pv_d0(o, vb0, pa0, pa1, pa2, pa3); partialSM(pB0, pB1, m_reg, mnB, alB);
  __syncthreads(); RESC(alB);
  finishSM(pB0, pB1, alB, l_reg, pa0, pa1, pa2, pa3); SBAR();
  pv_d0(o, vb0 + (int)SHM_V, pa0, pa1, pa2, pa3);
  if (hi == 0) li_l[r32] = l_reg; asm volatile("s_waitcnt lgkmcnt(0)" ::: "memory");
  float rli[16];
#pragma unroll
  for (int r = 0; r < 16; ++r) rli[r] = __builtin_amdgcn_rcpf(li_l[crow(r, hi)]);
  __syncthreads();
  { int lx = lane, r32x = r32, hix = hi; asm volatile("" : "+v"(lx), "+v"(r32x), "+v"(hix));
    const int wx = __builtin_amdgcn_readfirstlane(wid);
    unsigned short* Ow = Ob + (long)(wx * QBLK) * LDO;
    char* ot = lds + wx * 8704;
    char* otw = ot + (4 * hix) * 272 + r32x * 2;
#pragma unroll
    for (int r = 0; r < 16; ++r) { const int orow0 = (r & 3) + 8 * (r >> 2);
#pragma unroll
      for (int d0 = 0; d0 < 4; ++d0) *reinterpret_cast<unsigned short*>(otw + orow0 * 272 + d0 * 64) = (unsigned short)(cvtpk(o[d0][r] * rli[r], 0.f) & 0xffffu); }
    asm volatile("s_waitcnt lgkmcnt(0)" ::: "memory");
    const char* otr = ot + (lx >> 4) * 272 + (lx & 15) * 16; unsigned short* owr = Ow + (long)(lx >> 4) * LDO + (lx & 15) * 8;
#pragma unroll
    for (int j = 0; j < 8; ++j) { const u32x4 v = *reinterpret_cast<const u32x4*>(otr + j * 4 * 272); *reinterpret_cast<u32x4*>(owr + (long)(j * 4) * LDO) = v; } }
  __syncthreads();
#undef QSET
#undef SLOAD
#undef SWRITE
#undef SWAIT
#undef RESC
}
#undef SBAR
}
#define LAS __attribute__((address_space(3)))
typedef unsigned short bf16_t;
typedef float f32x4 __attribute__((ext_vector_type(4)));
typedef float f32x2 __attribute__((ext_vector_type(2)));
typedef unsigned u32x4 __attribute__((ext_vector_type(4)));
typedef unsigned u32x2 __attribute__((ext_vector_type(2)));
typedef short bf16x8 __attribute__((ext_vector_type(8)));
typedef short s16x4 __attribute__((ext_vector_type(4)));
constexpr int NB = 8, SEQ = 8192, DM = 1024, MT = NB * SEQ;
constexpr int NPROJ = 2560, INCOLS = 2512, DFF = 2816, NUP = 2 * DFF, PLE = 256;
constexpr int HALF_ROWS = MT / 2;
constexpr size_t MiB = 1u << 20;
constexpr size_t WS_SS = 0;
constexpr size_t WS_BAR = 1792 * 1024;
constexpr size_t WS_WIN = 2 * MiB, WS_WUQ = WS_WIN + (size_t)NPROJ * DM * 2, WS_WUKV = WS_WUQ + 768 * 256 * 2, WS_WOUT = WS_WUKV + 1024 * 128 * 2,
                 WS_WUP = WS_WOUT + (size_t)DM * DM * 2, WS_WDN = WS_WUP + (size_t)NUP * DM * 2, WS_WG = WS_WDN + (size_t)DM * DFF * 2, WS_WP = WS_WG + (size_t)DM * DM * 2,
                 WS_WEND = WS_WP + (size_t)DM * PLE * 2;
static_assert(WS_WEND <= 30 * MiB, "weights");
constexpr size_t WS_COS = 30 * MiB, WS_SIN = 31 * MiB;
constexpr size_t WS_MSC = 34 * MiB;
constexpr size_t WS_PB = 58 * MiB;
constexpr size_t WS_PR = 90 * MiB;
constexpr size_t WS_HF = 90 * MiB, WS_HB = 154 * MiB;
constexpr size_t WS_XN = 218 * MiB;
constexpr size_t WS_PROJ = 346 * MiB;
constexpr size_t WS_H1B = 346 * MiB;
constexpr size_t WS_UP = 474 * MiB;
constexpr size_t WS_ACT = 826 * MiB;
constexpr size_t WS_QB = 666 * MiB, WS_KVB = 762 * MiB, WS_KR = 890 * MiB;
constexpr size_t WS_DS = 1002 * MiB;
constexpr size_t WS_END = 1004 * MiB;
constexpr int LDS_BYTES = 155648;
static_assert(att::SHM_ATTN <= LDS_BYTES && pg8::STAGE_BYTES <= LDS_BYTES, "LDS map");

__device__ __forceinline__ float bf2f(bf16_t b) { return __uint_as_float(((unsigned)b) << 16); }
__device__ __forceinline__ unsigned pk2(float lo, float hi) { return pg8::cvt_pk_bf16(lo, hi); }
__device__ __forceinline__ bf16_t f2bf(float f) { return (bf16_t)(pg8::cvt_pk_bf16(f, 0.f) & 0xffffu); }
__device__ __forceinline__ float wave_sum(float v) {
#pragma unroll
    for (int o = 1; o < 64; o <<= 1) v += __shfl_xor(v, o);
    return v;
}
__device__ __forceinline__ float siluf(float x) { return x * __builtin_amdgcn_rcpf(1.f + __expf(-x)); }
__device__ __forceinline__ float sigmf(float x) { return __builtin_amdgcn_rcpf(1.f + __expf(-x)); }
#define LDS_WAIT() asm volatile("s_waitcnt lgkmcnt(0)" ::: "memory")

__device__ __forceinline__ int map_in(int n) {
    if (n < 2048) return n;
    if (n < 2064) return 2496 + (n - 2048);
    if (n < 2320) return 2048 + (n - 2064);
    if (n < 2448) return 2304 + (n - 2320);
    return 2432 + (n - 2448);
}
__device__ __forceinline__ int map_up(int n) { const int c = n < 2816 ? n : n - 2816; return (c >> 7) * 256 + (n < 2816 ? 0 : 128) + (c & 127); }
template <int MAPIN>
__device__ __forceinline__ void tr_item(const float* W, int K, int N, const float* gk, bf16_t* WT, LAS float* scr, int item, int lane) {
    const int nblk = (N + 31) / 32, kb = item / nblk, nb = item % nblk, k0 = 64 * kb, n0 = 32 * nb;
    const int nn = n0 + (lane & 31);
#pragma unroll 8
    for (int i = 0; i < 32; ++i) { const int kk = 2 * i + (lane >> 5); float v = (nn < N) ? W[(size_t)(k0 + kk) * N + nn] : 0.f; if (gk) v *= gk[k0 + kk]; scr[kk * 33 + (lane & 31)] = v; }
    LDS_WAIT(); asm volatile("" ::: "memory");
    const int c = lane & 7;
#pragma unroll
    for (int j = 0; j < 4; ++j) { const int nl = (lane >> 3) + 8 * j, n = n0 + nl; const LAS float* s = scr + (8 * c) * 33 + nl;
        u32x4 o; o.x = pk2(s[0 * 33], s[1 * 33]); o.y = pk2(s[2 * 33], s[3 * 33]); o.z = pk2(s[4 * 33], s[5 * 33]); o.w = pk2(s[6 * 33], s[7 * 33]);
        if (n < N) { const int dst = MAPIN == 1 ? map_in(n) : (MAPIN == 2 ? map_up(n) : n); *(u32x4*)(WT + (size_t)dst * K + k0 + 8 * c) = o; } }
    LDS_WAIT(); asm volatile("" ::: "memory");
}
struct Args { const float* in[23]; float* out; unsigned char* ws; int ph_lo, ph_hi; };
typedef Args P;
enum { I_X = 0, I_P, I_LNMIX, I_WIN, I_BG, I_CQKW, I_CQKB, I_MNG, I_QNG, I_WUQ, I_KVNG, I_WUKV, I_WOUT, I_LNFFN, I_WUP, I_CFW, I_CFB, I_WDN, I_PLENG, I_WG, I_WP, I_PPOST, I_FINAL };

__device__ __forceinline__ void p0_prologue(const P& a, LAS unsigned char* lds, int G) {
    const int tid = threadIdx.x, lane = tid & 63, wave = tid >> 6;
    const int gw = blockIdx.x * 8 + wave, NGW = G * 8; const size_t gt = (size_t)blockIdx.x * 512 + tid, NGT = (size_t)G * 512;
    unsigned char* ws = a.ws;
    if (blockIdx.x == 0) { unsigned* bw = (unsigned*)(ws + WS_BAR); for (int i = tid; i < 3456; i += 512) bw[i] = 0u; }
    { float* ss = (float*)(ws + WS_SS); for (size_t i = gt; i < (size_t)6 * MT; i += NGT) ss[i] = 0.f;
      unsigned* pad = (unsigned*)(ws + WS_WIN + (size_t)INCOLS * DM * 2); for (size_t i = gt; i < (size_t)(NPROJ - INCOLS) * DM / 2; i += NGT) pad[i] = 0u; }
    LAS float* scr = (LAS float*)(lds + wave * 16384);
    constexpr int I0 = 16 * 79, I1 = 4 * 24, I2 = 2 * 32, I3 = 16 * 32, I4 = 16 * 176, I5 = 44 * 32, I6 = 16 * 32, I7 = 4 * 32;
    constexpr int NITEMS = I0 + I1 + I2 + I3 + I4 + I5 + I6 + I7;
    for (int it = gw; it < NITEMS; it += NGW) {
        int r = it;
        if (r < I0) { tr_item<1>(a.in[I_WIN], DM, INCOLS, nullptr, (bf16_t*)(ws + WS_WIN), scr, r, lane); continue; } r -= I0;
        if (r < I1) { tr_item<0>(a.in[I_WUQ], 256, 768, a.in[I_QNG], (bf16_t*)(ws + WS_WUQ), scr, r, lane); continue; } r -= I1;
        if (r < I2) { tr_item<0>(a.in[I_WUKV], 128, 1024, a.in[I_KVNG], (bf16_t*)(ws + WS_WUKV), scr, r, lane); continue; } r -= I2;
        if (r < I3) { tr_item<0>(a.in[I_WOUT], DM, DM, nullptr, (bf16_t*)(ws + WS_WOUT), scr, r, lane); continue; } r -= I3;
        if (r < I4) { tr_item<2>(a.in[I_WUP], DM, NUP, a.in[I_LNFFN], (bf16_t*)(ws + WS_WUP), scr, r, lane); continue; } r -= I4;
        if (r < I5) { tr_item<0>(a.in[I_WDN], DFF, DM, nullptr, (bf16_t*)(ws + WS_WDN), scr, r, lane); continue; } r -= I5;
        if (r < I6) { tr_item<0>(a.in[I_WG], DM, DM, a.in[I_PLENG], (bf16_t*)(ws + WS_WG), scr, r, lane); continue; } r -= I6;
        tr_item<0>(a.in[I_WP], PLE, DM, nullptr, (bf16_t*)(ws + WS_WP), scr, r, lane);
    }
    { const float* g = a.in[I_LNMIX]; f32x4 gv[4];
#pragma unroll
      for (int j = 0; j < 4; ++j) gv[j] = *((const f32x4*)g + lane + 64 * j);
      for (int m = gw; m < MT; m += NGW) { const f32x4* xr = (const f32x4*)(a.in[I_X] + (size_t)m * DM) + lane; f32x4 v[4]; float s = 0.f;
#pragma unroll
        for (int j = 0; j < 4; ++j) { v[j] = __builtin_nontemporal_load(xr + 64 * j); s += pg8::sq4(v[j]); }
        const float rstd = rsqrtf(wave_sum(s) * (1.f / DM) + MK_EPS);
        u32x2* o8 = (u32x2*)((bf16_t*)(ws + WS_XN) + (size_t)m * DM) + lane;
#pragma unroll
        for (int j = 0; j < 4; ++j) { const f32x4 y = v[j] * rstd * gv[j]; u32x2 w; w.x = pk2(y[0], y[1]); w.y = pk2(y[2], y[3]); o8[64 * j] = w; } } }
    { const f32x4* p4 = (const f32x4*)a.in[I_P]; u32x4* o = (u32x4*)(ws + WS_PB);
      for (size_t i = gt; i < (size_t)MT * PLE / 8; i += NGT) { const f32x4 v0 = __builtin_nontemporal_load(p4 + 2 * i), v1 = __builtin_nontemporal_load(p4 + 2 * i + 1); o[i] = pg8::pack8(v0, v1); } }
    { float* ct = (float*)(ws + WS_COS); float* st = (float*)(ws + WS_SIN);
      for (size_t i = gt; i < (size_t)SEQ * 32; i += NGT) { const int pos = (int)(i >> 5), c = (int)(i & 31);
        const float invf = powf(10000.f, -(float)(2 * c) / 64.f); const float ang = (float)pos * invf;
        const double ad = (double)ang; const double k = rint(ad * 0.15915494309189535); const float r = (float)(ad - k * 6.283185307179586);
        ct[i] = __cosf(r); st[i] = __sinf(r); } }
}
namespace ml {
constexpr int RS = 272;
constexpr int O_KS = 0, O_KT = 34816, O_VT = 69632, O_WVT = 78336, O_CS = 87040, O_VEC = 95744, O_CH = 99328, O_END = 100608;
constexpr int O_LF = 0, O_IP = 33024;
using f32x4 = ::f32x4;
__device__ __forceinline__ f32x4 mfma16(bf16x8 a, bf16x8 b, f32x4 c) { return __builtin_amdgcn_mfma_f32_16x16x32_bf16(a, b, c, 0, 0, 0); }
struct ConvW { f32x4 w[3][2]; f32x4 b[2]; };
__device__ __forceinline__ ConvW load_convw(const float* cw, const float* cb, int col) { ConvW c;
#pragma unroll
    for (int k = 0; k < 3; ++k) { c.w[k][0] = *(const f32x4*)(cw + k * 1024 + col); c.w[k][1] = *(const f32x4*)(cw + k * 1024 + col + 4); }
    c.b[0] = *(const f32x4*)(cb + col); c.b[1] = *(const f32x4*)(cb + col + 4); return c; }
__device__ __forceinline__ u32x4 conv8w(const u32x4 xm, const u32x4 x0, const u32x4 xp, const ConvW& c, float scale) {
    const unsigned m_[4] = {xm.x, xm.y, xm.z, xm.w}, c_[4] = {x0.x, x0.y, x0.z, x0.w}, p_[4] = {xp.x, xp.y, xp.z, xp.w}; unsigned o[4];
#pragma unroll
    for (int i = 0; i < 4; ++i) { const int hv = i >> 1, j = (2 * i) & 3;
        const float vl = pg8::bf_lo(m_[i]) * c.w[0][hv][j] + pg8::bf_lo(c_[i]) * c.w[1][hv][j] + pg8::bf_lo(p_[i]) * c.w[2][hv][j] + c.b[hv][j];
        const float vh = pg8::bf_hi(m_[i]) * c.w[0][hv][j + 1] + pg8::bf_hi(c_[i]) * c.w[1][hv][j + 1] + pg8::bf_hi(p_[i]) * c.w[2][hv][j + 1] + c.b[hv][j + 1];
        o[i] = pk2(siluf(vl) * scale, siluf(vh) * scale); }
    u32x4 w; w.x = o[0]; w.y = o[1]; w.z = o[2]; w.w = o[3]; return w;
}
__device__ __forceinline__ void qkv_prep_unit(LAS unsigned char* lds, int unit, const bf16_t* proj, const float* conv_w, const float* conv_b, const float* b_gates,
                                              bf16_t* Qc, bf16_t* KTg, bf16_t* VTg, bf16_t* hf, bf16_t* hb, float* dsg) {
    const int tid = threadIdx.x, wid = tid >> 6, lane = tid & 63, l15 = lane & 15, q4 = lane >> 4; const int b = unit >> 8, cp = (unit >> 2) & 63, h = unit & 3; const size_t tokb = (size_t)b * SEQ;
    constexpr int O_K = 0, O_V = 34816, O_Q = 69632, O_VTL = 104448, O_GV = 139264;
    LAS float* LFi = (LAS float*)(lds + O_GV); LAS float* IPi = LFi + 256; LAS float* U2 = LFi + 512; LAS float* PM2 = LFi + 768;
    const u32x4 z = {0u, 0u, 0u, 0u};
    if (tid < 256) { const int p = tid & 127, d = tid >> 7, pos = cp * 128 + p; const bf16_t* row = proj + (tokb + pos) * NPROJ + 2496; const int ci = (2 * d) * 4 + h, cf = (2 * d + 1) * 4 + h;
        const float ip = bf2f(row[ci]) + b_gates[ci], fp = bf2f(row[cf]) + b_gates[cf]; LFi[d * 128 + p] = fminf(fp, 0.f) - log1pf(__expf(-fabsf(fp))); IPi[d * 128 + p] = ip; }
    { const int e0 = (tid & 15) * 8; const ConvW cq = load_convw(conv_w, conv_b, h * 128 + e0), ck = load_convw(conv_w, conv_b, 512 + h * 128 + e0);
#pragma unroll
      for (int it = 0; it < 4; ++it) { const int i = tid + 512 * it, p = i >> 4, pos = cp * 128 + p; const bf16_t* rp = proj + (tokb + pos) * NPROJ + h * 128 + e0;
        { const u32x4 x0 = *(const u32x4*)rp, xm = pos > 0 ? *(const u32x4*)(rp - NPROJ) : z, xp = pos < SEQ - 1 ? *(const u32x4*)(rp + NPROJ) : z;
          const u32x4 w = conv8w(xm, x0, xp, cq, 1.f); *(u32x4*)(Qc + (tokb + pos) * 512 + h * 128 + e0) = w; *(LAS u32x4*)(lds + O_Q + p * RS + e0 * 2) = w; }
        { const bf16_t* rk = rp + 512; const u32x4 x0 = *(const u32x4*)rk, xm = pos > 0 ? *(const u32x4*)(rk - NPROJ) : z, xp = pos < SEQ - 1 ? *(const u32x4*)(rk + NPROJ) : z;
          *(LAS u32x4*)(lds + O_K + p * RS + e0 * 2) = conv8w(xm, x0, xp, ck, 0.08838834764831845f); }
        *(LAS u32x4*)(lds + O_V + p * RS + e0 * 2) = *(const u32x4*)(rp + 1024); } }
    __syncthreads();
    if (wid < 2) { const int d = wid, p0 = d ? 127 - 2 * lane : 2 * lane, p1 = d ? p0 - 1 : p0 + 1;
        const float lf0 = LFi[d * 128 + p0], lf1 = LFi[d * 128 + p1], i0 = IPi[d * 128 + p0], i1 = IPi[d * 128 + p1];
        float inc = lf0 + lf1;
#pragma unroll
        for (int o = 1; o < 64; o <<= 1) { const float t = __shfl_up(inc, o); if (lane >= o) inc += t; }
        const float g0 = inc - lf1, g1 = inc; const float u0 = i0 - g0, u1 = i1 - g1;
        float mx = fmaxf(u0, u1);
#pragma unroll
        for (int o = 1; o < 64; o <<= 1) { const float t = __shfl_up(mx, o); if (lane >= o) mx = fmaxf(mx, t); }
        float ex = __shfl_up(mx, 1); if (lane == 0) ex = -INFINITY;
        const float pm0 = fmaxf(ex, u0), pm1 = fmaxf(pm0, u1);
        U2[d * 128 + p0] = u0 * 1.4426950408889634f; U2[d * 128 + p1] = u1 * 1.4426950408889634f; PM2[d * 128 + p0] = pm0 * 1.4426950408889634f; PM2[d * 128 + p1] = pm1 * 1.4426950408889634f; }
#pragma unroll
    for (int it = 0; it < 4; ++it) { const int i = tid + 512 * it, e = i & 127, p0 = (i >> 7) * 8; unsigned short kv[8], vv[8];
#pragma unroll
        for (int j = 0; j < 8; ++j) { kv[j] = *(const LAS bf16_t*)(lds + O_K + (p0 + j) * RS + e * 2); vv[j] = *(const LAS bf16_t*)(lds + O_V + (p0 + j) * RS + e * 2); }
        u32x4 wk, wv; wk.x = kv[0] | ((unsigned)kv[1] << 16); wk.y = kv[2] | ((unsigned)kv[3] << 16); wk.z = kv[4] | ((unsigned)kv[5] << 16); wk.w = kv[6] | ((unsigned)kv[7] << 16);
        wv.x = vv[0] | ((unsigned)vv[1] << 16); wv.y = vv[2] | ((unsigned)vv[3] << 16); wv.z = vv[4] | ((unsigned)vv[5] << 16); wv.w = vv[6] | ((unsigned)vv[7] << 16);
        *(u32x4*)(KTg + (size_t)unit * 16384 + e * 128 + p0) = wk; *(u32x4*)(VTg + (size_t)unit * 16384 + e * 128 + p0) = wv; *(LAS u32x4*)(lds + O_VTL + e * RS + p0 * 2) = wv; }
    __syncthreads();
    bf16x8 qf[4];
#pragma unroll
    for (int kk = 0; kk < 4; ++kk) qf[kk] = *(const LAS bf16x8*)(lds + O_Q + (16 * wid + l15) * RS + (32 * kk + 8 * q4) * 2);
    f32x4 sa[8];
#pragma unroll
    for (int n = 0; n < 8; ++n) { sa[n] = (f32x4){0.f, 0.f, 0.f, 0.f};
#pragma unroll
        for (int kk = 0; kk < 4; ++kk) { const bf16x8 kf = *(const LAS bf16x8*)(lds + O_K + (16 * n + l15) * RS + (32 * kk + 8 * q4) * 2); sa[n] = mfma16(kf, qf[kk], sa[n]); }
        if ((n & 3) == 3) __builtin_amdgcn_sched_barrier(0); }
    __syncthreads();
    const int tl = wid * 16 + l15; const size_t tok0 = tokb + (size_t)cp * 128;
#pragma unroll
    for (int d = 0; d < 2; ++d) {
        const float pmt = PM2[d * 128 + tl]; float dsum = 0.f; f32x4 accP[8];
#pragma unroll
        for (int dt = 0; dt < 8; ++dt) accP[dt] = (f32x4){0.f, 0.f, 0.f, 0.f};
#pragma unroll
        for (int kk = 0; kk < 4; ++kk) { float pv[8];
#pragma unroll
            for (int hh = 0; hh < 2; ++hh) { const int n = 2 * kk + hh; const f32x4 u4 = *(const LAS f32x4*)(U2 + d * 128 + 16 * n + 4 * q4);
#pragma unroll
                for (int r = 0; r < 4; ++r) { const int s = 16 * n + 4 * q4 + r; const bool ok = d ? (s >= tl) : (s <= tl); const float p = ok ? sa[n][r] * __builtin_amdgcn_exp2f(u4[r] - pmt) : 0.f; pv[4 * hh + r] = p; dsum += p; } }
            u32x4 pw; pw.x = pk2(pv[0], pv[1]); pw.y = pk2(pv[2], pv[3]); pw.z = pk2(pv[4], pv[5]); pw.w = pk2(pv[6], pv[7]);
#pragma unroll
            for (int dt = 0; dt < 8; ++dt) { const LAS unsigned char* vp = lds + O_VTL + (16 * dt + l15) * RS + (32 * kk + 4 * q4) * 2;
                const u32x2 va = *(const LAS u32x2*)vp, vb = *(const LAS u32x2*)(vp + 32); u32x4 vw; vw.x = va.x; vw.y = va.y; vw.z = vb.x; vw.w = vb.y;
                accP[dt] = mfma16(*reinterpret_cast<bf16x8*>(&pw), *reinterpret_cast<bf16x8*>(&vw), accP[dt]); } }
        dsum += __shfl_xor(dsum, 16); dsum += __shfl_xor(dsum, 32);
        if (q4 == 0) dsg[((size_t)d * MT + tok0 + tl) * 4 + h] = dsum;
        { LAS unsigned char* nt = lds + O_K + wid * 4352;
#pragma unroll
          for (int dt = 0; dt < 8; ++dt)
#pragma unroll
              for (int r = 0; r < 4; ++r) *(LAS bf16_t*)(nt + (4 * q4 + r) * RS + (16 * dt + l15) * 2) = f2bf(accP[dt][r]);
          LDS_WAIT();
          bf16_t* hd = (d ? hb : hf) + (tok0 + wid * 16) * 512 + h * 128;
#pragma unroll
          for (int j = 0; j < 4; ++j) { const int c = j * 64 + lane, row = c >> 4, ch = c & 15; const u32x4 v = *(const LAS u32x4*)(nt + row * RS + ch * 16); *(u32x4*)(hd + (size_t)row * 512 + ch * 8) = v; } }
    }
    __syncthreads();
}
constexpr int N_KT = 0, N_VT = 69632, N_CS = 87040, N_VEC = 113152, N_CH = 121344, N_END = 122624;
__device__ __forceinline__ void mlstm_item(LAS unsigned char* lds, int item, const bf16_t* proj, const float* b_gates, float* msc_all,
                                           const bf16_t* Qc, const bf16_t* KTg, const bf16_t* VTg, bf16_t* hf, bf16_t* hb, const float* dsg, bf16_t* hfw, bf16_t* hbw) {
    const int tid = threadIdx.x, wid = tid >> 6, lane = tid & 63, l15 = lane & 15, q4 = lane >> 4;
    const int xcd = item & 7, slot = item >> 3, db = slot & 3, bhd = xcd * 8 + (slot >> 2), b = bhd >> 3, h = (bhd >> 1) & 3, dir = bhd & 1;
    float* mscG = msc_all + (size_t)item * 3 * SEQ; float* mscU = mscG + SEQ; float* mscPM = mscU + SEQ;
    LAS float* LF = (LAS float*)(lds + O_LF); LAS float* IP = (LAS float*)(lds + O_IP);
    LAS float* VEC = (LAS float*)(lds + N_VEC); LAS float* NV = VEC + 1024;
    LAS float* GL = (LAS float*)(lds + N_CH); LAS float* PML = GL + 64; LAS float* MPREV = GL + 128; LAS float* SOLD = GL + 192; LAS float* SNEW = GL + 256;
    const size_t tokb = (size_t)b * SEQ;
    __syncthreads();
    { const int ci = (2 * dir) * 4 + h, cf = (2 * dir + 1) * 4 + h; const float bi = b_gates[ci], bfv = b_gates[cf];
#pragma unroll 4
      for (int j = tid; j < SEQ; j += 512) { const int pos = dir ? SEQ - 1 - j : j; const bf16_t* row = proj + (tokb + pos) * NPROJ + 2496;
        const float ip = bf2f(row[ci]) + bi, fp = bf2f(row[cf]) + bfv; const float lf = fminf(fp, 0.f) - log1pf(__expf(-fabsf(fp)));
        LF[j + (j >> 7)] = lf; IP[j + (j >> 7)] = ip; } }
    __syncthreads();
    for (int c = wid; c < 64; c += 8) {
        const float lf0 = LF[c * 129 + 2 * lane], lf1 = LF[c * 129 + 2 * lane + 1], i0 = IP[c * 129 + 2 * lane], i1 = IP[c * 129 + 2 * lane + 1];
        float inc = lf0 + lf1;
#pragma unroll
        for (int o = 1; o < 64; o <<= 1) { const float t = __shfl_up(inc, o); if (lane >= o) inc += t; }
        const float g0 = inc - lf1, g1 = inc, u0 = i0 - g0, u1 = i1 - g1;
        float mx = fmaxf(u0, u1);
#pragma unroll
        for (int o = 1; o < 64; o <<= 1) { const float t = __shfl_up(mx, o); if (lane >= o) mx = fmaxf(mx, t); }
        float ex = __shfl_up(mx, 1); if (lane == 0) ex = -INFINITY;
        const float pm0 = fmaxf(ex, u0), pm1 = fmaxf(pm0, u1);
        const int j0 = c * 128 + 2 * lane, p0 = dir ? SEQ - 1 - j0 : j0, p1 = dir ? p0 - 1 : p0 + 1;
        mscG[p0] = g0; mscU[p0] = u0; mscPM[p0] = pm0; mscG[p1] = g1; mscU[p1] = u1; mscPM[p1] = pm1;
        if (lane == 63) { GL[c] = g1; PML[c] = pm1; } }
    __syncthreads();
    if (wid == 0) { const float gl = GL[lane], mloc = gl + PML[lane]; float A = gl, B = mloc;
#pragma unroll
        for (int o = 1; o < 64; o <<= 1) { const float pA = __shfl_up(A, o), pB = __shfl_up(B, o); if (lane >= o) { B = fmaxf(pB + A, B); A = pA + A; } }
        const float mnew = fmaxf(A, B);
        float mprev = __shfl_up(mnew, 1); if (lane == 0) mprev = 0.f;
        MPREV[lane] = mprev; SOLD[lane] = __expf(gl + mprev - mnew); SNEW[lane] = __expf(mloc - mnew); }
    __syncthreads();
    for (int i = tid; i < 2 * 48 * RS / 4; i += 512) ((LAS unsigned*)(lds + N_CS))[i] = 0u;
    if (tid < 128) NV[tid] = 0.f;
    f32x4 Creg[2] = {(f32x4){0.f, 0.f, 0.f, 0.f}, (f32x4){0.f, 0.f, 0.f, 0.f}};
    __threadfence_block();
    __syncthreads();
    bf16_t* hout = dir ? hb : hf; bf16_t* houtw = dir ? hbw : hfw; const float* dsd = dsg + (size_t)dir * MT * 4;
    u32x4 ktreg[4], vtreg, qreg[4]; float vu = 0.f, vpm = 0.f, vg = 0.f; unsigned short ni[2][4]; float dsi[4];
    const int sp = tid >> 4, se0 = (tid & 15) * 8;
    const unsigned voO = (unsigned)((wid * 16 + 4 * q4) * 512 + l15) * 2u, voD = (unsigned)((wid * 16 + 4 * q4) * 4) * 4u;
    const unsigned voK2 = (unsigned)((wid * 16 + l15) * 128 + 8 * q4) * 2u;
    const unsigned voT = (unsigned)(sp * 128 + se0) * 2u, voQ = (unsigned)((wid * 16 + l15) * 512 + 8 * q4) * 2u, voM = (unsigned)tid * 4u;
#define ML_PREFETCH(cc) do { const int cp_ = dir ? 63 - (cc) : (cc); const size_t unit_ = ((size_t)b * 64 + cp_) * 4 + h; const size_t t0_ = tokb + (size_t)cp_ * 128; \
        const char* tb_ = (const char*)(KTg + unit_ * 16384); const char* vb_ = (const char*)(VTg + unit_ * 16384 + (size_t)db * 32 * 128); const char* qb_ = (const char*)(Qc + t0_ * 512 + h * 128); \
        const char* hb_ = (const char*)(hout + t0_ * 512 + h * 128 + db * 32); const char* db_ = (const char*)(dsd + t0_ * 4 + h); \
        _Pragma("unroll") for (int kk = 0; kk < 4; ++kk) { ktreg[kk] = *(const u32x4*)(tb_ + voK2 + 64 * kk); } \
        vtreg = *(const u32x4*)(vb_ + voT); \
        _Pragma("unroll") for (int kk = 0; kk < 4; ++kk) qreg[kk] = *(const u32x4*)(qb_ + voQ + 64 * kk); \
        _Pragma("unroll") for (int r = 0; r < 4; ++r) { ni[0][r] = *(const unsigned short*)(hb_ + voO + r * 1024); ni[1][r] = *(const unsigned short*)(hb_ + voO + r * 1024 + 32); dsi[r] = *(const float*)(db_ + voD + r * 16); } \
        if (tid < 128) { vu = *(const float*)((const char*)(mscU + cp_ * 128) + voM); vpm = *(const float*)((const char*)(mscPM + cp_ * 128) + voM); vg = *(const float*)((const char*)(mscG + cp_ * 128) + voM); } } while (0)
#define ML_STAGE(cc, bf_) do { \
        *(LAS u32x4*)(lds + N_VT + (bf_) * 8704 + sp * RS + se0 * 2) = vtreg; \
        if (tid < 128) { const float mp = MPREV[cc], Mt = fmaxf(vpm, mp); LAS float* V_ = VEC + (bf_) * 512 + tid; \
            V_[0] = __expf(vpm - Mt); V_[128] = __expf(mp - Mt); V_[256] = __expf(-(vg + Mt)); V_[384] = __expf(vu - PML[cc]); } } while (0)
    ML_PREFETCH(0);
    ML_STAGE(0, 0);
    bf16x8 qf[4], kcur[4]; float numI[2][4], dsI[4];
#pragma unroll
    for (int kk = 0; kk < 4; ++kk) { qf[kk] = *reinterpret_cast<bf16x8*>(&qreg[kk]); kcur[kk] = *reinterpret_cast<bf16x8*>(&ktreg[kk]); }
#pragma unroll
    for (int r = 0; r < 4; ++r) { numI[0][r] = bf2f(ni[0][r]); numI[1][r] = bf2f(ni[1][r]); dsI[r] = dsi[r]; }
    ML_PREFETCH(1);
    __syncthreads();
    for (int c = 0; c < 64; ++c) {
        const int cp = dir ? 63 - c : c, bufo = c & 1;
        int l15x = l15, q4x = q4; asm volatile("" : "+v"(l15x), "+v"(q4x));
        LAS unsigned char* KTb = lds + N_KT + bufo * 34816; LAS unsigned char* VTb = lds + N_VT + bufo * 8704; LAS unsigned char* CSr = lds + N_CS + bufo * 13056; LAS unsigned char* CSw = lds + N_CS + (bufo ^ 1) * 13056;
        LAS float* RT = VEC + bufo * 512; LAS float* INTER = RT + 128; LAS float* FLOOR = RT + 256; LAS float* Wv = RT + 384;
        f32x4 accY[3]; bf16x8 cfr[3][4]; float inr[4], rtr[4], flr[4];
#pragma unroll
        for (int dt = 0; dt < 3; ++dt)
#pragma unroll
            for (int kk = 0; kk < 4; ++kk) cfr[dt][kk] = *(const LAS bf16x8*)(CSr + (16 * dt + l15x) * RS + (32 * kk + 8 * q4x) * 2);
        { const f32x4 i4 = *(const LAS f32x4*)(INTER + wid * 16 + 4 * q4x), r4 = *(const LAS f32x4*)(RT + wid * 16 + 4 * q4x), f4 = *(const LAS f32x4*)(FLOOR + wid * 16 + 4 * q4x);
#pragma unroll
          for (int r = 0; r < 4; ++r) { inr[r] = i4[r]; rtr[r] = r4[r]; flr[r] = f4[r]; } }
        __builtin_amdgcn_sched_barrier(0);
#pragma unroll
        for (int dt = 0; dt < 3; ++dt) { accY[dt] = (f32x4){0.f, 0.f, 0.f, 0.f};
#pragma unroll
            for (int kk = 0; kk < 4; ++kk) accY[dt] = mfma16(qf[kk], cfr[dt][kk], accY[dt]); }
#pragma unroll
        for (int r = 0; r < 4; ++r) { const float nq = __shfl(accY[2][r], lane & 48); const float in = inr[r], rt = rtr[r];
            const float den = rt * dsI[r] + in * nq; const float sc = __builtin_amdgcn_rcpf(fmaxf(fabsf(den), flr[r]));
            bf16_t* op = (bf16_t*)((char*)(houtw + (tokb + (size_t)cp * 128) * 512 + h * 128 + db * 32) + voO + r * 1024);
            op[0] = f2bf((rt * numI[0][r] + in * accY[0][r]) * sc); op[16] = f2bf((rt * numI[1][r] + in * accY[1][r]) * sc); }
        { const float so = SOLD[c], sn = SNEW[c];
          f32x4 wq[4][2]; u32x4 vwr[2][4]; bf16x8 kfr[4];
#pragma unroll
          for (int kk = 0; kk < 4; ++kk) { wq[kk][0] = *(const LAS f32x4*)(Wv + 32 * kk + 8 * q4x); wq[kk][1] = *(const LAS f32x4*)(Wv + 32 * kk + 8 * q4x + 4);
              vwr[0][kk] = *(const LAS u32x4*)(VTb + l15x * RS + (32 * kk + 8 * q4x) * 2); vwr[1][kk] = *(const LAS u32x4*)(VTb + (16 + l15x) * RS + (32 * kk + 8 * q4x) * 2);
              kfr[kk] = kcur[kk]; }
          const float nvo = NV[16 * wid + l15x];
          __builtin_amdgcn_sched_barrier(0);
#pragma unroll
          for (int dt = 0; dt < 2; ++dt) { f32x4 ac = (f32x4){0.f, 0.f, 0.f, 0.f};
#pragma unroll
              for (int kk = 0; kk < 4; ++kk) { const u32x4 vw = vwr[dt][kk];
                  u32x4 aw; aw.x = pk2(pg8::bf_lo(vw.x) * wq[kk][0][0], pg8::bf_hi(vw.x) * wq[kk][0][1]); aw.y = pk2(pg8::bf_lo(vw.y) * wq[kk][0][2], pg8::bf_hi(vw.y) * wq[kk][0][3]);
                  aw.z = pk2(pg8::bf_lo(vw.z) * wq[kk][1][0], pg8::bf_hi(vw.z) * wq[kk][1][1]); aw.w = pk2(pg8::bf_lo(vw.w) * wq[kk][1][2], pg8::bf_hi(vw.w) * wq[kk][1][3]);
                  ac = mfma16(*reinterpret_cast<bf16x8*>(&aw), kfr[kk], ac); }
              Creg[dt] = Creg[dt] * so + ac * sn;
#pragma unroll
              for (int r = 0; r < 4; ++r) *(LAS bf16_t*)(CSw + (16 * dt + 4 * q4x + r) * RS + (16 * wid + l15x) * 2) = f2bf(Creg[dt][r]); }
          { f32x4 an = (f32x4){0.f, 0.f, 0.f, 0.f};
#pragma unroll
            for (int kk = 0; kk < 4; ++kk) { u32x4 aw = {0u, 0u, 0u, 0u};
                if (l15x == 0) { aw.x = pk2(wq[kk][0][0], wq[kk][0][1]); aw.y = pk2(wq[kk][0][2], wq[kk][0][3]); aw.z = pk2(wq[kk][1][0], wq[kk][1][1]); aw.w = pk2(wq[kk][1][2], wq[kk][1][3]); }
                an = mfma16(*reinterpret_cast<bf16x8*>(&aw), kfr[kk], an); }
            if (q4x == 0) { const float nn = nvo * so + an[0] * sn; NV[16 * wid + l15x] = nn; *(LAS bf16_t*)(CSw + 32 * RS + (16 * wid + l15x) * 2) = f2bf(nn); } } }
        if (c + 1 < 64) {
            ML_STAGE(c + 1, bufo ^ 1);
#pragma unroll
            for (int kk = 0; kk < 4; ++kk) { qf[kk] = *reinterpret_cast<bf16x8*>(&qreg[kk]); kcur[kk] = *reinterpret_cast<bf16x8*>(&ktreg[kk]); }
#pragma unroll
            for (int r = 0; r < 4; ++r) { numI[0][r] = bf2f(ni[0][r]); numI[1][r] = bf2f(ni[1][r]); dsI[r] = dsi[r]; }
            if (c + 2 < 64) ML_PREFETCH(c + 2);
        }
        __syncthreads();
    }
#undef ML_STAGE
#undef ML_PREFETCH
}
}
__device__ __forceinline__ void k_rope_phase(const P& a, int G) {
    const bf16_t* proj = (const bf16_t*)(a.ws + WS_PROJ); bf16_t* kr = (bf16_t*)(a.ws + WS_KR); const float* ct = (const float*)(a.ws + WS_COS); const float* st = (const float*)(a.ws + WS_SIN);
    for (size_t i = (size_t)blockIdx.x * 512 + threadIdx.x; i < (size_t)MT * 32; i += (size_t)G * 512) { const size_t tok = i >> 5; const int c = (int)(i & 31), pos = (int)(tok & (SEQ - 1));
        const float x1 = bf2f(proj[tok * NPROJ + 2432 + c]), x2 = bf2f(proj[tok * NPROJ + 2464 + c]), cs = ct[pos * 32 + c], sn = st[pos * 32 + c];
        kr[tok * 64 + c] = f2bf(x1 * cs - x2 * sn); kr[tok * 64 + 32 + c] = f2bf(x2 * cs + x1 * sn); }
}
__device__ __forceinline__ void combine_rows(const P& a, int G) {
    const int lane = threadIdx.x & 63, wv = threadIdx.x >> 6;
    const bf16_t* proj = (const bf16_t*)(a.ws + WS_PROJ); const bf16_t* hf = (const bf16_t*)(a.ws + WS_HF); const bf16_t* hb = (const bf16_t*)(a.ws + WS_HB); bf16_t* y = (bf16_t*)(a.ws + WS_XN);
    const f32x4 g0 = *(const f32x4*)(a.in[I_MNG] + lane * 8), g1 = *(const f32x4*)(a.in[I_MNG] + lane * 8 + 4);
    for (int pm = blockIdx.x; pm < MT / 256; pm += G)
    for (int m = pm * 256 + wv; m < pm * 256 + 256; m += 8) {
        const u32x4 f = *(const u32x4*)(hf + (size_t)m * 512 + lane * 8), bk = *(const u32x4*)(hb + (size_t)m * 512 + lane * 8), ow = *(const u32x4*)(proj + (size_t)m * NPROJ + 1536 + lane * 8);
        const unsigned f_[4] = {f.x, f.y, f.z, f.w}, b_[4] = {bk.x, bk.y, bk.z, bk.w}, o_[4] = {ow.x, ow.y, ow.z, ow.w};
        float v[8]; float s = 0.f;
#pragma unroll
        for (int i = 0; i < 4; ++i) { v[2 * i] = pg8::bf_lo(f_[i]) + pg8::bf_lo(b_[i]); v[2 * i + 1] = pg8::bf_hi(f_[i]) + pg8::bf_hi(b_[i]); s += v[2 * i] * v[2 * i] + v[2 * i + 1] * v[2 * i + 1]; }
        s += __shfl_xor(s, 1); s += __shfl_xor(s, 2); s += __shfl_xor(s, 4); s += __shfl_xor(s, 8);
        const float rstd = rsqrtf(s * (1.f / 128.f) + MK_EPS);
        float r[8];
#pragma unroll
        for (int i = 0; i < 4; ++i) { r[2 * i] = v[2 * i] * rstd * (i < 2 ? g0[2 * i] : g1[2 * i - 4]) * sigmf(pg8::bf_lo(o_[i])); r[2 * i + 1] = v[2 * i + 1] * rstd * (i < 2 ? g0[2 * i + 1] : g1[2 * i - 3]) * sigmf(pg8::bf_hi(o_[i])); }
        u32x4 w; w.x = pk2(r[0], r[1]); w.y = pk2(r[2], r[3]); w.z = pk2(r[4], r[5]); w.w = pk2(r[6], r[7]);
        *(u32x4*)(y + (size_t)m * 1024 + lane * 8) = w;
    }
}
__device__ __forceinline__ void ffn_conv_phase(const P& a, int G, int bid) {
    const bf16_t* up = (const bf16_t*)(a.ws + WS_UP); bf16_t* act = (bf16_t*)(a.ws + WS_ACT); const float* cw = a.in[I_CFW]; const float* cb = a.in[I_CFB];
    constexpr int NCC = DFF / 8, RUN = 16; const size_t NIT = (size_t)(HALF_ROWS / RUN) * NCC;
    for (size_t id = (size_t)bid * 512 + threadIdx.x; id < NIT; id += (size_t)G * 512) {
        const int cc = (int)(id % NCC), run = (int)(id / NCC), r0 = run * RUN, t0 = r0 & (SEQ - 1), c0 = cc * 8;
        float wg[3][8], wv[3][8], bg[8], bv[8];
#pragma unroll
        for (int k = 0; k < 3; ++k)
#pragma unroll
            for (int j = 0; j < 8; ++j) { wg[k][j] = cw[k * NUP + c0 + j]; wv[k][j] = cw[k * NUP + DFF + c0 + j]; }
#pragma unroll
        for (int j = 0; j < 8; ++j) { bg[j] = cb[c0 + j]; bv[j] = cb[DFF + c0 + j]; }
        const u32x4 z = {0u, 0u, 0u, 0u};
        u32x4 gm = t0 > 0 ? *(const u32x4*)(up + (size_t)(r0 - 1) * NUP + c0) : z, vm = t0 > 0 ? *(const u32x4*)(up + (size_t)(r0 - 1) * NUP + DFF + c0) : z;
        u32x4 g0 = *(const u32x4*)(up + (size_t)r0 * NUP + c0), v0 = *(const u32x4*)(up + (size_t)r0 * NUP + DFF + c0);
#pragma unroll 4
        for (int i = 0; i < RUN; ++i) { const bool has = (t0 + i + 1) < SEQ;
            const u32x4 gp = has ? *(const u32x4*)(up + (size_t)(r0 + i + 1) * NUP + c0) : z, vp = has ? *(const u32x4*)(up + (size_t)(r0 + i + 1) * NUP + DFF + c0) : z;
            const unsigned gm_[4] = {gm.x, gm.y, gm.z, gm.w}, g0_[4] = {g0.x, g0.y, g0.z, g0.w}, gp_[4] = {gp.x, gp.y, gp.z, gp.w}, vm_[4] = {vm.x, vm.y, vm.z, vm.w}, v0_[4] = {v0.x, v0.y, v0.z, v0.w}, vp_[4] = {vp.x, vp.y, vp.z, vp.w};
            float o[8];
#pragma unroll
            for (int k = 0; k < 4; ++k) {
                const float gl = pg8::bf_lo(gm_[k]) * wg[0][2 * k] + pg8::bf_lo(g0_[k]) * wg[1][2 * k] + pg8::bf_lo(gp_[k]) * wg[2][2 * k] + bg[2 * k];
                const float gh = pg8::bf_hi(gm_[k]) * wg[0][2 * k + 1] + pg8::bf_hi(g0_[k]) * wg[1][2 * k + 1] + pg8::bf_hi(gp_[k]) * wg[2][2 * k + 1] + bg[2 * k + 1];
                const float vl = pg8::bf_lo(vm_[k]) * wv[0][2 * k] + pg8::bf_lo(v0_[k]) * wv[1][2 * k] + pg8::bf_lo(vp_[k]) * wv[2][2 * k] + bv[2 * k];
                const float vh = pg8::bf_hi(vm_[k]) * wv[0][2 * k + 1] + pg8::bf_hi(v0_[k]) * wv[1][2 * k + 1] + pg8::bf_hi(vp_[k]) * wv[2][2 * k + 1] + bv[2 * k + 1];
                o[2 * k] = siluf(gl) * vl; o[2 * k + 1] = siluf(gh) * vh; }
            u32x4 w; w.x = pk2(o[0], o[1]); w.y = pk2(o[2], o[3]); w.z = pk2(o[4], o[5]); w.w = pk2(o[6], o[7]);
            *(u32x4*)(act + (size_t)(r0 + i) * DFF + c0) = w;
            gm = g0; vm = v0; g0 = gp; v0 = vp; }
    }
}
__device__ __forceinline__ void final_norm_phase(const P& a, int G) {
    const int lane = threadIdx.x & 63, gw = blockIdx.x * 8 + (threadIdx.x >> 6), NGW = G * 8; const float* ss3 = (const float*)(a.ws + WS_SS) + (size_t)5 * MT;
    f32x4 gv[4];
#pragma unroll
    for (int j = 0; j < 4; ++j) gv[j] = *((const f32x4*)a.in[I_FINAL] + lane + 64 * j);
    for (int m = gw; m < MT; m += NGW) { f32x4* xr = (f32x4*)(a.out + (size_t)m * DM) + lane; const float rstd = rsqrtf(ss3[m] * (1.f / DM) + MK_EPS);
#pragma unroll
        for (int j = 0; j < 4; ++j) xr[64 * j] = xr[64 * j] * rstd * gv[j]; }
}

typedef unsigned long long gu64_unused_t;
#define XB_TMO      128
#define XB_XCNT(j)  (256  + 64 * (j))
#define XB_XSUB(j)  (1280 + 64 * (j))
#define XB_XGEN(j)  (2304 + 64 * (j))
#define XB_TOP      3328
#define XB_TOPGEN   3392
#define XCD_BAR_WORDS 3456
#define XB_SPIN_CAP (1u << 18)

__device__ __forceinline__ unsigned xb_ld(unsigned* p)              { return __hip_atomic_load(p, __ATOMIC_RELAXED, __HIP_MEMORY_SCOPE_AGENT); }
__device__ __forceinline__ unsigned xb_add(unsigned* p, unsigned v) { return __hip_atomic_fetch_add(p, v, __ATOMIC_RELAXED, __HIP_MEMORY_SCOPE_AGENT); }
__device__ __forceinline__ unsigned xb_xcc_id() { return (unsigned)__builtin_amdgcn_s_getreg((3 << 11) | 20) & 0xFu; }
#define XB_SPIN(cond, bar) do { unsigned _sp = 0; while (cond) { __builtin_amdgcn_s_sleep(1); \
    if ((++_sp & 255u) == 0u) { if (xb_ld(&(bar)[XB_TMO])) break; if (_sp > XB_SPIN_CAP) { atomicAdd(&(bar)[XB_TMO], 1u); break; } } } } while (0)

struct XcdBarrier {
    unsigned* bar; unsigned x;
    volatile LAS unsigned* st;
};

__device__ __forceinline__ XcdBarrier xcd_barrier_post(unsigned* bar, volatile LAS unsigned* st) {
    XcdBarrier b; b.bar = bar; b.x = xb_xcc_id(); b.st = st;
    if (threadIdx.x == 0) (void)xb_add(&bar[XB_XCNT(b.x)], 1u);
    return b;
}
__device__ __forceinline__ void xcd_barrier_complete(unsigned* bar, unsigned x, unsigned& nloc, unsigned& nx) {
    const unsigned G = gridDim.x * gridDim.y * gridDim.z;
    unsigned sum, cnt, mine, sp = 0u;
    for (;;) {
        sum = 0u; cnt = 0u; mine = 0u;
#pragma unroll
        for (unsigned j = 0; j < 16; ++j) { const unsigned c = xb_ld(&bar[XB_XCNT(j)]); sum += c; cnt += (c > 0u) ? 1u : 0u; mine = (j == x) ? c : mine; }
        if (sum == G) break;
        __builtin_amdgcn_s_sleep(1);
        if ((++sp & 255u) == 0u) { if (xb_ld(&bar[XB_TMO])) break; if (sp > XB_SPIN_CAP) { atomicAdd(&bar[XB_TMO], 1u); break; } }
    }
    nloc = mine > 0u ? mine : 1u; nx = cnt > 0u ? cnt : 1u;
}

__device__ __forceinline__ void xcd_barrier(const XcdBarrier& b) {
    asm volatile("s_waitcnt vmcnt(0)" ::: "memory");
    __syncthreads();
    if (threadIdx.x == 0) {
        unsigned* bar = b.bar;
        __builtin_amdgcn_s_waitcnt(0);
        unsigned nloc = b.st[0], nx = b.st[1];
        if (nloc == 0u) { xcd_barrier_complete(bar, b.x, nloc, nx); b.st[0] = nloc; b.st[1] = nx; }
        const unsigned old = xb_add(&bar[XB_XSUB(b.x)], 1u);
        const unsigned gen = old / nloc;
        if (old + 1u == (gen + 1u) * nloc) {
            __builtin_amdgcn_fence(__ATOMIC_RELEASE, "agent");
            asm volatile("s_waitcnt vmcnt(0)" ::: "memory");
            const unsigned og = xb_add(&bar[XB_TOP], 1u);
            const unsigned tg = og / nx;
            if (og + 1u == (tg + 1u) * nx) xb_add(&bar[XB_TOPGEN], 1u);
            else XB_SPIN(xb_ld(&bar[XB_TOPGEN]) == tg, bar);
            __builtin_amdgcn_fence(__ATOMIC_ACQUIRE, "agent");
            xb_add(&bar[XB_XGEN(b.x)], 1u);
            asm volatile("s_waitcnt vmcnt(0)" ::: "memory");
        } else {
            XB_SPIN(xb_ld(&bar[XB_XGEN(b.x)]) == gen, bar);
            __builtin_amdgcn_fence(__ATOMIC_ACQUIRE, "agent");
            asm volatile("s_waitcnt vmcnt(0)" ::: "memory");
        }
    }
    __syncthreads();
}


constexpr int NPH = 8;
__global__ void __launch_bounds__(512, 2) mega_fwd(Args args) {
    extern __shared__ __attribute__((aligned(16))) unsigned char lds_raw[];
    LAS unsigned char* lds = (LAS unsigned char*)lds_raw;
    const Args& a = args;
    const int G = gridDim.x, lo = args.ph_lo, hi = args.ph_hi;
    volatile LAS unsigned* bst = (volatile LAS unsigned*)(lds + LDS_BYTES - 16);
    if (threadIdx.x < 4) bst[threadIdx.x] = 0u;
    __syncthreads();
    unsigned* barw = (unsigned*)(args.ws + WS_BAR);
    XcdBarrier xb; xb.bar = barw; xb.x = 0; xb.st = bst;
    unsigned char* ws = args.ws;
    float* ssq = (float*)(ws + WS_SS); float* sskv = ssq + MT; float* ss1 = ssq + 2 * (size_t)MT; float* ss2 = ssq + 3 * (size_t)MT; float* ssp = ssq + 4 * (size_t)MT; float* ss3 = ssq + 5 * (size_t)MT;
#ifdef ONLY_PH
#define IN(k) ((k) == ONLY_PH)
#else
#define IN(k) (lo <= (k) && (k) < hi)
#endif
#if MK_N_LAUNCHES == 1
#define SEAM(k) do { if (IN(k) && IN((k) + 1)) { if ((k) == 0) { cg::this_grid().sync(); xb = xcd_barrier_post(barw, bst); } else xcd_barrier(xb); } } while (0)
#else
#define SEAM(k) do { } while (0)
#endif
    if (MK_REP_SYNC > 1) { for (int i = 0; i < 12; ++i) cg::this_grid().sync(); }
    if (IN(0)) { p0_prologue(a, lds, G); if (MK_REP_SMALL > 1) { __syncthreads(); int Gl = G; asm volatile("" : "+s"(Gl)); p0_prologue(a, lds, Gl); } } SEAM(0);
    if (IN(1)) {
        pg8::Gemm g{(const bf16_t*)(ws + WS_XN), (const bf16_t*)(ws + WS_WIN), MT, NPROJ, DM, DM, 0}; pg8::StaticOrder S; S.init(MT, NPROJ, G, (int)blockIdx.x);
        pg8::EpiProj E{(bf16_t*)(ws + WS_PROJ), NPROJ, ssq, sskv};
        pg8::gemm_phase<pg8::EpiProj, pg8::StaticOrder, true, true>(lds, g, S, E);
    } SEAM(1);
    if (IN(2)) {
        { pg8::Gemm g{(const bf16_t*)(ws + WS_PROJ) + 2048, (const bf16_t*)(ws + WS_WUQ), MT, 768, 256, NPROJ, 0}; pg8::StaticOrder S; S.init(MT, 768, G, (int)blockIdx.x);
          pg8::EpiScale E{(bf16_t*)(ws + WS_QB), 768, ssq, 1.f / 256.f, nullptr};
          pg8::gemm_phase<pg8::EpiScale, pg8::StaticOrder, true, true>(lds, g, S, E); }
        { pg8::Gemm g{(const bf16_t*)(ws + WS_PROJ) + 2304, (const bf16_t*)(ws + WS_WUKV), MT, 1024, 128, NPROJ, 0}; pg8::StaticOrder S; S.init(MT, 1024, G, (int)blockIdx.x);
          pg8::EpiScale E{(bf16_t*)(ws + WS_KVB), 1024, sskv, 1.f / 128.f, nullptr};
          pg8::gemm_phase<pg8::EpiScale, pg8::StaticOrder, true, true>(lds, g, S, E); }
        k_rope_phase(a, G);
        __syncthreads();
        for (int rep = 0; rep < MK_REP_P2; ++rep)
        for (int u = blockIdx.x; u < 2048; u += G)
            ml::qkv_prep_unit(lds, u, (const bf16_t*)(ws + WS_PROJ), a.in[I_CQKW], a.in[I_CQKB], a.in[I_BG], (bf16_t*)a.out, (bf16_t*)a.out + (size_t)MT * 1024, (bf16_t*)a.out + (size_t)MT * 1536,
                              (bf16_t*)(ws + WS_HF), (bf16_t*)(ws + WS_HB), (float*)(ws + WS_DS));
    } SEAM(2);
    if (IN(3)) {
#ifndef SKIP_ML
        if (MK_REP_ML > 1) { int Gl = G; asm volatile("" : "+s"(Gl));
            for (int it = blockIdx.x; it < 256; it += Gl)
                ml::mlstm_item(lds, it, (const bf16_t*)(ws + WS_PROJ), a.in[I_BG], (float*)(ws + WS_MSC), (const bf16_t*)a.out, (const bf16_t*)a.out + (size_t)MT * 1024,
                               (const bf16_t*)a.out + (size_t)MT * 1536, (bf16_t*)(ws + WS_HF), (bf16_t*)(ws + WS_HB), (const float*)(ws + WS_DS), (bf16_t*)(ws + 898 * MiB), (bf16_t*)(ws + 898 * MiB)); }
        for (int it = blockIdx.x; it < 256; it += G)
            ml::mlstm_item(lds, it, (const bf16_t*)(ws + WS_PROJ), a.in[I_BG], (float*)(ws + WS_MSC), (const bf16_t*)a.out, (const bf16_t*)a.out + (size_t)MT * 1024,
                           (const bf16_t*)a.out + (size_t)MT * 1536, (bf16_t*)(ws + WS_HF), (bf16_t*)(ws + WS_HB), (const float*)(ws + WS_DS), (bf16_t*)(ws + WS_HF), (bf16_t*)(ws + WS_HB));
#endif
        __syncthreads();
#ifndef SKIP_ATT
        for (int rep = 0; rep < MK_REP_ATT; ++rep)
        for (int it = blockIdx.x; it < 1024; it += G) {
            int bh, qb; if (G == 256) { bh = (it >> 8) * 8 + (it & 7); qb = (it & 255) >> 3; } else { bh = it >> 5; qb = it & 31; }
            const int b = bh >> 2, h = bh & 3; const size_t tokb = (size_t)b * SEQ;
            const att::bf16* Q = (const att::bf16*)(ws + WS_QB) + (tokb + (size_t)qb * 256) * 768 + h * 192;
            const att::bf16* Kn = (const att::bf16*)(ws + WS_KVB) + tokb * 1024 + h * 256; const att::bf16* Vh = Kn + 128;
            const att::bf16* Kr = (const att::bf16*)(ws + WS_KR) + tokb * 64;
            unsigned short* O = (unsigned short*)(ws + WS_XN) + (tokb + (size_t)qb * 256) * 1024 + 512 + h * 128;
            att::attn_unit(Q, Kn, Vh, Kr, O, (const float*)(ws + WS_COS), (const float*)(ws + WS_SIN), qb * 256, SEQ, (char*)lds_raw);
        }
#endif
    } SEAM(3);
    if (IN(4)) {
        combine_rows(a, G);
        asm volatile("s_waitcnt vmcnt(0)" ::: "memory"); __syncthreads(); __builtin_amdgcn_fence(__ATOMIC_ACQUIRE, "agent"); asm volatile("s_waitcnt vmcnt(0)" ::: "memory"); __syncthreads();
        { pg8::Gemm g{(const bf16_t*)(ws + WS_XN), (const bf16_t*)(ws + WS_WOUT), MT, DM, DM, DM, 0}; pg8::PanelOrder S{(int)blockIdx.x, G, MT / 256};
          pg8::EpiResid E{a.in[I_X], a.out, (bf16_t*)(ws + WS_H1B), DM, ss1};
          pg8::gemm_phase<pg8::EpiResid, pg8::PanelOrder, true, true>(lds, g, S, E); }
        { pg8::Gemm g{(const bf16_t*)(ws + WS_PB), (const bf16_t*)(ws + WS_WP), MT, DM, PLE, PLE, 0}; pg8::StaticOrder S; S.init(MT, DM, G, (int)blockIdx.x);
          pg8::EpiScale E{(bf16_t*)(ws + WS_PR), DM, nullptr, 0.f, ssp};
          pg8::gemm_phase<pg8::EpiScale, pg8::StaticOrder, true, true>(lds, g, S, E); }
    } SEAM(4);
    if (IN(5)) {
        pg8::Gemm g{(const bf16_t*)(ws + WS_H1B) - DM, (const bf16_t*)(ws + WS_WUP), 264 * 256, NUP, DM, DM, 1}; pg8::StaticOrder S; S.init(264 * 256, NUP, G, (int)blockIdx.x);
        pg8::EpiConvAct E{(bf16_t*)(ws + WS_UP), ss1, a.in[I_CFW], a.in[I_CFB]};
        pg8::gemm_phase<pg8::EpiConvAct, pg8::StaticOrder, true, true>(lds, g, S, E);
        if (MK_REP_UP > 1) { __syncthreads(); pg8::gemm_phase<pg8::EpiConvAct, pg8::StaticOrder, true, true>(lds, g, S, E); }
    } SEAM(5);
    if (IN(6)) {
        pg8::Gemm g{(const bf16_t*)(ws + WS_UP), (const bf16_t*)(ws + WS_WDN), MT, DM, DFF, DFF, 0}; pg8::StaticOrder S; S.init(MT, DM, G, (int)blockIdx.x);
        pg8::EpiResid E{a.out, a.out, (bf16_t*)(ws + WS_XN), DM, ss2};
        pg8::gemm_phase<pg8::EpiResid, pg8::StaticOrder, true, true>(lds, g, S, E);
    } SEAM(6);
    if (IN(7)) {
        {
            pg8::Gemm g{(const bf16_t*)(ws + WS_XN), (const bf16_t*)(ws + WS_WG), MT, DM, DM, DM, 0}; pg8::PanelOrder S{(int)blockIdx.x, G, MT / 256};
            pg8::EpiPle E{a.out, (const bf16_t*)(ws + WS_PR), DM, ss2, ssp, a.in[I_PPOST], nullptr};
            pg8::gemm_phase<pg8::EpiPle, pg8::PanelOrder, true, true>(lds, g, S, E);
            asm volatile("s_waitcnt vmcnt(0)" ::: "memory"); __syncthreads(); __builtin_amdgcn_fence(__ATOMIC_ACQUIRE, "agent"); asm volatile("s_waitcnt vmcnt(0)" ::: "memory"); __syncthreads();
            { const int lane = threadIdx.x & 63, wv = threadIdx.x >> 6; f32x4 gv[4];
#pragma unroll
              for (int j = 0; j < 4; ++j) gv[j] = *((const f32x4*)a.in[I_FINAL] + lane + 64 * j);
              for (int pm = blockIdx.x; pm < MT / 256; pm += G)
              for (int r = wv; r < 256; r += 8) { f32x4* xr = (f32x4*)(a.out + ((size_t)pm * 256 + r) * DM) + lane; f32x4 v[4]; float sq = 0.f;
#pragma unroll
                  for (int j = 0; j < 4; ++j) { v[j] = xr[64 * j]; sq += pg8::sq4(v[j]); }
                  const float rstd = rsqrtf(wave_sum(sq) * (1.f / DM) + MK_EPS);
#pragma unroll
                  for (int j = 0; j < 4; ++j) __builtin_nontemporal_store(v[j] * rstd * gv[j], xr + 64 * j); } }
        }
    } SEAM(7);
#undef IN
#undef SEAM
}

extern "C" void kernel_launch(void* const* d_in, const int* in_sizes, int n_in, void* d_out, int out_size, void* d_ws, size_t ws_size, hipStream_t stream) {
    static int grid = 0;
    if (grid == 0) {
        if (n_in != 23 || in_sizes[0] != MT * DM || out_size != MT * DM || ws_size < WS_END) { fprintf(stderr, "kernel_launch: unexpected shapes (n_in %d, in0 %d, out %d, ws %zu)\n", n_in, n_in > 0 ? in_sizes[0] : -1, out_size, ws_size); grid = -1; return; }
        int dev = 0, cus = 0, per_cu = 0;
        if (hipGetDevice(&dev) != hipSuccess || hipDeviceGetAttribute(&cus, hipDeviceAttributeMultiprocessorCount, dev) != hipSuccess) { grid = -1; return; }
        if (hipFuncSetAttribute((const void*)mega_fwd, hipFuncAttributeMaxDynamicSharedMemorySize, LDS_BYTES) != hipSuccess) { fprintf(stderr, "kernel_launch: hipFuncSetAttribute failed\n"); grid = -1; return; }
        if (hipOccupancyMaxActiveBlocksPerMultiprocessor(&per_cu, (const void*)mega_fwd, 512, LDS_BYTES) != hipSuccess || per_cu < 1) { fprintf(stderr, "kernel_launch: occupancy query says %d\n", per_cu); per_cu = 1; }
        (void)hipGetLastError();
        grid = cus;
    }
    if (grid < 0) return;
    Args a{};
    for (int i = 0; i < 23; ++i) a.in[i] = (const float*)d_in[i];
    a.out = (float*)d_out; a.ws = (unsigned char*)d_ws;
#if MK_N_LAUNCHES == 1
    a.ph_lo = 0; a.ph_hi = NPH;
    void* params[] = {&a};
    hipError_t e = hipLaunchCooperativeKernel((const void*)mega_fwd, dim3(grid), dim3(512), params, LDS_BYTES, stream);
    if (e != hipSuccess) fprintf(stderr, "kernel_launch: cooperative launch failed: %s (grid %d)\n", hipGetErrorString(e), grid);
#else
    for (int p = 0; p < NPH; ++p) { a.ph_lo = p; a.ph_hi = p + 1; hipLaunchKernelGGL(mega_fwd, dim3(grid), dim3(512), LDS_BYTES, stream, a); }
#endif
}
```
